# Optimizing an MI355X kernel written in HIP

```python
import jax, jax.numpy as jnp
from jax import lax
import numpy as np

D_MODEL = 1024
BATCH = 4
SEQ = 8192
DEPTH = 4

GRID_W = 64
CTX_LEN = 256
N_MIXERS = 4
GROUP_W = D_MODEL // N_MIXERS
HEAD_DIM = 64
N_Q_HEADS = GROUP_W // HEAD_DIM
N_KV_HEADS = N_Q_HEADS // 2
GQA_GROUP = N_Q_HEADS // N_KV_HEADS
KV_W = N_KV_HEADS * HEAD_DIM
AXIS_DIM = HEAD_DIM // 2
ROPE_THETA = 10000.0
ATTN_SCALE = HEAD_DIM ** -0.5
Q_BLOCK = 128
SHORT_CONV_K = 3
CONFORMER_K = 31
CHUNK = 128
N_SPATIAL_GROUPS = 4
RMS_EPS = 1e-6
LN_EPS = 1e-5

PROJ_WIDTHS = (GROUP_W, GROUP_W, GROUP_W, GROUP_W,
               2 * GROUP_W, GROUP_W,
               GROUP_W, GROUP_W, GROUP_W,
               GROUP_W, KV_W, KV_W, GROUP_W)
PROJ_W = sum(PROJ_WIDTHS)
SPLIT_IDX = tuple(int(i) for i in np.cumsum(PROJ_WIDTHS)[:-1])
KV_START = SPLIT_IDX[9]
KV_END = SPLIT_IDX[11]

kernel_name = "hybrid_parallel_group_dit_trunk"


def rms_norm(x, g):
    xf = x.astype(jnp.float32)
    y = xf * lax.rsqrt(jnp.mean(xf * xf, axis=-1, keepdims=True) + RMS_EPS)
    return (y * g.astype(jnp.float32)).astype(x.dtype)


def layer_norm(x, g, b):
    xf = x.astype(jnp.float32)
    mu = jnp.mean(xf, axis=-1, keepdims=True)
    xc = xf - mu
    y = xc * lax.rsqrt(jnp.mean(xc * xc, axis=-1, keepdims=True) + LN_EPS)
    return (y * g.astype(jnp.float32) + b.astype(jnp.float32)).astype(x.dtype)


def dwconv(x, w):
    k = w.shape[0]
    return lax.conv_general_dilated(
        x, w[:, None, :].astype(x.dtype), window_strides=(1,), padding=[(k // 2, k // 2)],
        dimension_numbers=('NWC', 'WIO', 'NWC'), feature_group_count=x.shape[-1])


def short_conv_mixer(b_gate, c_gate, h, w):
    return b_gate * dwconv(c_gate * h, w)


def conformer_conv_mixer(glu_in, w, bias, ln_g, ln_b):
    a, g = jnp.split(glu_in, 2, axis=-1)
    z = a * jax.nn.sigmoid(g)
    z = dwconv(z, w) + bias
    return jax.nn.silu(layer_norm(z, ln_g, ln_b))


def chunk_mlp_mixer(u, v, ln_g, ln_b, w_s, b_s):
    bsz, s, ch = v.shape
    v = layer_norm(v, ln_g, ln_b)
    vc = v.reshape(bsz, s // CHUNK, CHUNK, N_SPATIAL_GROUPS, ch // N_SPATIAL_GROUPS)
    sg = jnp.einsum('gij,bnjgc->bnigc', w_s.astype(v.dtype), vc) + b_s.T[:, :, None].astype(v.dtype)
    return u * sg.reshape(bsz, s, ch)


def rope_axis(x, cos, sin):
    x1, x2 = jnp.split(x, 2, axis=-1)
    return jnp.concatenate([x1 * cos - x2 * sin, x2 * cos + x1 * sin], axis=-1)


def rope_2d(x, cos_r, sin_r, cos_c, sin_c):
    xr, xc = jnp.split(x, 2, axis=-1)
    return jnp.concatenate([rope_axis(xr, cos_r, sin_r), rope_axis(xc, cos_c, sin_c)], axis=-1)


def split_heads(t, n_heads):
    return t.reshape(t.shape[:-1] + (n_heads, HEAD_DIM))


def attend(q, k, v):
    bsz, nq = q.shape[:2]
    qg = q.reshape(bsz, nq, N_KV_HEADS, GQA_GROUP, HEAD_DIM)
    s = jnp.einsum('bqkgd,btkd->bkgqt', qg, k).astype(jnp.float32) * ATTN_SCALE
    p = jax.nn.softmax(s, axis=-1).astype(v.dtype)
    o = jnp.einsum('bkgqt,btkd->bqkgd', p, v)
    return o.reshape(bsz, nq, N_Q_HEADS * HEAD_DIM)


def attend_blocks(q, k, v):
    bsz, s = q.shape[:2]
    nb = s // Q_BLOCK
    qb = q.reshape(bsz, nb, Q_BLOCK, N_Q_HEADS, HEAD_DIM).swapaxes(0, 1)
    o = lax.map(lambda qi: attend(qi, k, v), qb)
    return o.swapaxes(0, 1).reshape(bsz, s, N_Q_HEADS * HEAD_DIM)


def mixer_output(parts, att, conv_a_l, conv_b_l, conv_b_bias_l, conf_ln_g_l, conf_ln_b_l,
                 sgu_ln_g_l, sgu_ln_b_l, w_s_l, b_s_l, w_out_l):
    a_b, a_c, a_h, a_g, b_glu, b_g, c_u, c_v, c_g = parts[:9]
    d_g = parts[12]
    ya = short_conv_mixer(a_b, a_c, a_h, conv_a_l)
    yb = conformer_conv_mixer(b_glu, conv_b_l, conv_b_bias_l, conf_ln_g_l, conf_ln_b_l)
    yc = chunk_mlp_mixer(c_u, c_v, sgu_ln_g_l, sgu_ln_b_l, w_s_l, b_s_l)
    y = jnp.concatenate([ya * jax.nn.silu(a_g), yb * jax.nn.silu(b_g),
                         yc * jax.nn.silu(c_g), att * jax.nn.silu(d_g)], axis=-1)
    return y @ w_out_l


def setup_inputs(seed: int = 0) -> dict:
    key = jax.random.key(seed)
    ks = jax.random.split(key, 24)
    f32 = jnp.float32
    nrm = lambda k, shape, s: jax.random.normal(k, shape, f32) * s
    return {
        "x": nrm(ks[0], (BATCH, SEQ, D_MODEL), 1.0),
        "c": nrm(ks[1], (BATCH, D_MODEL), 1.0),
        "ctx": nrm(ks[2], (BATCH, CTX_LEN, D_MODEL), 1.0),
        "c_ctx": nrm(ks[3], (D_MODEL,), 1.0),
        "w_mod": nrm(ks[4], (DEPTH, D_MODEL, 3 * D_MODEL), D_MODEL ** -0.5),
        "b_mod": nrm(ks[5], (DEPTH, 3 * D_MODEL), 0.02),
        "g_pre": 1.0 + nrm(ks[6], (DEPTH, D_MODEL), 0.02),
        "g_post": 1.0 + nrm(ks[7], (DEPTH, D_MODEL), 0.02),
        "w_in": nrm(ks[8], (DEPTH, D_MODEL, PROJ_W), D_MODEL ** -0.5),
        "w_out": nrm(ks[9], (DEPTH, D_MODEL, D_MODEL), D_MODEL ** -0.5),
        "conv_a": nrm(ks[10], (DEPTH, SHORT_CONV_K, GROUP_W), SHORT_CONV_K ** -0.5),
        "conv_b": nrm(ks[11], (DEPTH, CONFORMER_K, GROUP_W), CONFORMER_K ** -0.5),
        "conv_b_bias": nrm(ks[12], (DEPTH, GROUP_W), 0.02),
        "conf_ln_g": 1.0 + nrm(ks[13], (DEPTH, GROUP_W), 0.02),
        "conf_ln_b": nrm(ks[14], (DEPTH, GROUP_W), 0.02),
        "sgu_ln_g": 1.0 + nrm(ks[15], (DEPTH, GROUP_W), 0.02),
        "sgu_ln_b": nrm(ks[16], (DEPTH, GROUP_W), 0.02),
        "w_s": nrm(ks[17], (DEPTH, N_SPATIAL_GROUPS, CHUNK, CHUNK), CHUNK ** -0.5),
        "b_s": 1.0 + nrm(ks[18], (DEPTH, N_SPATIAL_GROUPS, CHUNK), 0.1),
        "q_gain": 1.0 + nrm(ks[19], (DEPTH, HEAD_DIM), 0.02),
        "k_gain": 1.0 + nrm(ks[20], (DEPTH, HEAD_DIM), 0.02),
    }


def reference(x, c, ctx, c_ctx, w_mod, b_mod, g_pre, g_post, w_in, w_out, conv_a, conv_b, conv_b_bias,
              conf_ln_g, conf_ln_b, sgu_ln_g, sgu_ln_b, w_s, b_s, q_gain, k_gain):
    bsz, s, _ = x.shape
    rows = s // GRID_W
    r_idx, c_idx = jnp.meshgrid(jnp.arange(rows), jnp.arange(GRID_W), indexing='ij')
    pos_row = r_idx.reshape(-1).astype(jnp.float32)
    pos_col = c_idx.reshape(-1).astype(jnp.float32)
    inv_freq = 1.0 / (ROPE_THETA ** (jnp.arange(0, AXIS_DIM, 2, dtype=jnp.float32) / AXIS_DIM))
    ang_r = pos_row[:, None] * inv_freq[None, :]
    ang_c = pos_col[:, None] * inv_freq[None, :]
    cos_r = jnp.cos(ang_r)[:, None, :].astype(x.dtype)
    sin_r = jnp.sin(ang_r)[:, None, :].astype(x.dtype)
    cos_c = jnp.cos(ang_c)[:, None, :].astype(x.dtype)
    sin_c = jnp.sin(ang_c)[:, None, :].astype(x.dtype)

    xc = ctx
    for l in range(DEPTH):
        last = l == DEPTH - 1
        mod_l = (jax.nn.silu(c) @ w_mod[l] + b_mod[l])[:, None, :]
        mod_c = (jax.nn.silu(c_ctx) @ w_mod[l] + b_mod[l])[None, None, :]
        sh, sc, gt = jnp.split(mod_l, 3, axis=-1)
        sh_c, sc_c, gt_c = jnp.split(mod_c, 3, axis=-1)
        h = rms_norm(x, g_pre[l]) * (1.0 + sc) + sh
        hc = rms_norm(xc, g_pre[l]) * (1.0 + sc_c) + sh_c

        parts = jnp.split(h @ w_in[l], SPLIT_IDX, axis=-1)
        if last:
            k_c, v_c = jnp.split(hc @ w_in[l][:, KV_START:KV_END], 2, axis=-1)
            parts_c = None
        else:
            parts_c = jnp.split(hc @ w_in[l], SPLIT_IDX, axis=-1)
            k_c, v_c = parts_c[10], parts_c[11]
        k_c = rms_norm(split_heads(k_c, N_KV_HEADS), k_gain[l])
        v_c = split_heads(v_c, N_KV_HEADS)

        q = rope_2d(rms_norm(split_heads(parts[9], N_Q_HEADS), q_gain[l]), cos_r, sin_r, cos_c, sin_c)
        k = rope_2d(rms_norm(split_heads(parts[10], N_KV_HEADS), k_gain[l]), cos_r, sin_r, cos_c, sin_c)
        v = split_heads(parts[11], N_KV_HEADS)
        k_all = jnp.concatenate([k_c, k], axis=1)
        v_all = jnp.concatenate([v_c, v], axis=1)
        att = attend_blocks(q, k_all, v_all)

        y = mixer_output(parts, att, conv_a[l], conv_b[l], conv_b_bias[l], conf_ln_g[l], conf_ln_b[l],
                         sgu_ln_g[l], sgu_ln_b[l], w_s[l], b_s[l], w_out[l])

        if not last:
            q_c = rms_norm(split_heads(parts_c[9], N_Q_HEADS), q_gain[l])
            att_c = attend(q_c, k_c, v_c)
            y_c = mixer_output(parts_c, att_c, conv_a[l], conv_b[l], conv_b_bias[l], conf_ln_g[l], conf_ln_b[l],
                               sgu_ln_g[l], sgu_ln_b[l], w_s[l], b_s[l], w_out[l])
            xc = xc + gt_c * rms_norm(y_c, g_post[l])

        x = x + gt * rms_norm(y, g_post[l])
    return x
```

```cpp
#include <hip/hip_runtime.h>
#include <hip/hip_cooperative_groups.h>
#include <cstdio>
#include <cstdint>
namespace cg = cooperative_groups;

#ifndef MK_COOP
#define MK_COOP 1
#endif

typedef unsigned short u16;
using bf16x8 = __attribute__((ext_vector_type(8))) short;
using f32x16 = __attribute__((ext_vector_type(16))) float;
using f32x4  = __attribute__((ext_vector_type(4))) float;
using u32x4  = __attribute__((ext_vector_type(4))) unsigned;
using u32x2  = __attribute__((ext_vector_type(2))) unsigned;
#define DI __device__ __forceinline__
#define MFMA32(a, b, c) __builtin_amdgcn_mfma_f32_32x32x16_bf16((a), (b), (c), 0, 0, 0)

constexpr int DM = 1024, BATCH = 4, SEQ = 8192, DEPTH = 4, CTX = 256, PW = 3328;
constexpr int NLAT = BATCH * SEQ;
constexpr int NROWS = NLAT + BATCH * CTX;
constexpr int TKV = CTX + SEQ;
constexpr int NTHREADS = 512;
constexpr int LDS_BYTES = 140 * 1024;
constexpr float QSCALE = 0.125f * 1.4426950408889634f;

constexpr int C_AB = 0, C_AC = 256, C_AH = 512, C_AG = 768, C_BGLU = 1024, C_BG = 1536, C_CU = 1792, C_CV = 2048,
              C_CG = 2304, C_Q = 2560, C_K = 2816, C_V = 2944, C_DG = 3072;

constexpr int PWO = 1792, O_CX = 0, O_ABG = 256, O_Z = 512, O_SBG = 768, O_UG = 1024, O_CV = 1280, O_SDG = 1536;
constexpr size_t WS_WTIN = 0;
constexpr size_t WS_WTOUT = WS_WTIN + (size_t)DEPTH * PW * DM * 2;
constexpr size_t WS_WSBF = WS_WTOUT + (size_t)DEPTH * DM * DM * 2;
constexpr size_t WS_MOD = WS_WSBF + (size_t)DEPTH * 4 * 128 * 128 * 2;
constexpr size_t WS_ROPE = WS_MOD + (size_t)DEPTH * 5 * 3072 * 4;
constexpr size_t WS_H = WS_ROPE + (size_t)128 * 16 * 2 * 4;
constexpr size_t WS_P = WS_H + (size_t)NROWS * DM * 2;
constexpr size_t WS_Q = WS_P + (size_t)NROWS * 1792 * 2;
constexpr size_t WS_K = WS_Q + (size_t)BATCH * 4 * TKV * 64 * 2;
constexpr size_t WS_VT = WS_K + (size_t)BATCH * 2 * TKV * 64 * 2;
constexpr size_t WS_YMIX = WS_VT + (size_t)BATCH * 2 * TKV * 64 * 2;
constexpr size_t WS_XC = WS_YMIX + (size_t)NROWS * DM * 2;
constexpr size_t WS_CTR = WS_XC + (size_t)NROWS * DM * 2;
constexpr size_t WS_BAR = WS_CTR + 64 * DEPTH;
constexpr size_t WS_PANEL = WS_BAR + 64;
constexpr size_t WS_XBAR = WS_PANEL + 64 * 4 * DEPTH;
constexpr size_t WS_MODCNT = WS_XBAR + 3456 * 4;
constexpr size_t WS_END = WS_MODCNT + 64;

struct Params {
    const float *x, *c, *ctx, *c_ctx, *w_mod, *b_mod, *g_pre, *g_post, *w_in, *w_out, *conv_a, *conv_b, *conv_b_bias,
        *conf_ln_g, *conf_ln_b, *sgu_ln_g, *sgu_ln_b, *w_s, *b_s, *q_gain, *k_gain;
    float* out;
    unsigned char* ws;
    int ph_lo, ph_hi;
};

DI unsigned f2bf(float x) { unsigned u = __float_as_uint(x); u += 0x7fffu + ((u >> 16) & 1u); return u >> 16; }
typedef __bf16 bf16x2_t __attribute__((ext_vector_type(2)));
typedef float f32x2_t __attribute__((ext_vector_type(2)));
DI unsigned pk2(float lo, float hi) { f32x2_t v = {lo, hi}; bf16x2_t r = __builtin_convertvector(v, bf16x2_t); return __builtin_bit_cast(unsigned, r); }
DI float bflo(unsigned u) { return __uint_as_float(u << 16); }
DI float bfhi(unsigned u) { return __uint_as_float(u & 0xffff0000u); }
DI float bf1(u16 u) { return __uint_as_float(((unsigned)u) << 16); }
DI float sigmoidf_(float x) { return 1.f / (1.f + __expf(-x)); }
DI float siluf_(float x) { return x / (1.f + __expf(-x)); }
DI int crow(int reg, int h) { return (reg & 3) + 8 * (reg >> 2) + 4 * h; }
DI void unpack8(u32x4 v, float* f) {
    f[0] = bflo(v[0]); f[1] = bfhi(v[0]); f[2] = bflo(v[1]); f[3] = bfhi(v[1]);
    f[4] = bflo(v[2]); f[5] = bfhi(v[2]); f[6] = bflo(v[3]); f[7] = bfhi(v[3]);
}
DI void unpack4(u32x2 v, float* f) { f[0] = bflo(v[0]); f[1] = bfhi(v[0]); f[2] = bflo(v[1]); f[3] = bfhi(v[1]); }
DI float wave_sum(float v) {
#pragma unroll
    for (int o = 1; o < 64; o <<= 1) v += __shfl_xor(v, o);
    return v;
}
DI int otid() { int t = threadIdx.x; asm volatile("" : "+v"(t)); return t; }
DI int obid() { int b = blockIdx.x; asm volatile("" : "+s"(b)); return b; }
DI int vbid() { const int b = obid(); const int per = gridDim.x >> 3; return (gridDim.x & 7) ? b : (b & 7) * per + (b >> 3); }
DI void grid_barrier(unsigned* cnt, unsigned target) {
    asm volatile("s_waitcnt vmcnt(0) lgkmcnt(0)" ::: "memory");
    __syncthreads();
    if (threadIdx.x == 0) {
        __builtin_amdgcn_fence(__ATOMIC_RELEASE, "agent");
        __hip_atomic_fetch_add(cnt, 1u, __ATOMIC_RELAXED, __HIP_MEMORY_SCOPE_AGENT);
        while (__hip_atomic_load(cnt, __ATOMIC_RELAXED, __HIP_MEMORY_SCOPE_AGENT) < target) __builtin_amdgcn_s_sleep(2);
        __builtin_amdgcn_fence(__ATOMIC_ACQUIRE, "agent");
        asm volatile("s_waitcnt vmcnt(0)" ::: "memory");
    }
    __syncthreads();
}

DI int swz(int row, int chunk) { return row * 128 + ((chunk ^ ((row >> 1) & 7)) << 4); }

DI int src_col(int n) {
    const int T = n >> 8, c = n & 255, bj = c >> 7, j = c & 127;
    switch (T) {
        case 0: case 1: return (bj ? C_AH : C_AC) + (T & 1) * 128 + j;
        case 2: case 3: return (bj ? C_AG : C_AB) + (T & 1) * 128 + j;
        case 4: case 5: return C_BGLU + (bj ? 256 : 0) + (T & 1) * 128 + j;
        case 6: return C_BG + c;
        case 7: case 8: return (bj ? C_CG : C_CU) + ((T - 7) & 1) * 128 + j;
        case 9: return C_CV + c;
        case 10: case 11: { const int wc = (c >> 5) & 3, fq = (c >> 3) & 3, nn = (c >> 2) & 1, e = c & 3; return (T << 8) + 64 * wc + 32 * bj + 16 * nn + 4 * fq + e; }
        default: return n;
    }
}
template <bool PERMUTE>
DI void transpose_item(const float* W, int N, u16* WT, int kb, int nb, float* scr) {
    const int tid = otid();
    const int k0 = kb * 64, n0 = nb * 128;
    const int n4 = (tid & 31) * 4, kr = tid >> 5;
    const int nsrc = PERMUTE ? src_col(n0 + n4) : n0 + n4;
    f32x4 v[4];
#pragma unroll
    for (int i = 0; i < 4; ++i) v[i] = *(const f32x4*)(W + (size_t)(k0 + kr + 16 * i) * N + nsrc);
#pragma unroll
    for (int i = 0; i < 4; ++i) {
        float* d = scr + (kr + 16 * i) * 129 + n4;
        d[0] = v[i][0]; d[1] = v[i][1]; d[2] = v[i][2]; d[3] = v[i][3];
    }
    __syncthreads();
    const int c = tid & 7;
#pragma unroll
    for (int j = 0; j < 2; ++j) {
        const int n = (tid >> 3) + 64 * j;
        const float* s = scr + (8 * c) * 129 + n;
        u32x4 o;
        o[0] = pk2(s[0], s[129]); o[1] = pk2(s[258], s[387]); o[2] = pk2(s[516], s[645]); o[3] = pk2(s[774], s[903]);
        *(u32x4*)(WT + (size_t)(n0 + n) * 1024 + k0 + 8 * c) = o;
    }
    __syncthreads();
}

DI void phase_prologue(const Params& p, unsigned char* lds) {
    float* scr = (float*)lds;
    const int tid = otid(), lane = tid & 63, wid = tid >> 6;
    u16* wtin = (u16*)(p.ws + WS_WTIN);
    u16* wtout = (u16*)(p.ws + WS_WTOUT);
    constexpr int I_IN = 16 * 26, I_OUT = 16 * 8;
    constexpr int N_TR = DEPTH * (I_IN + I_OUT);
    constexpr int N_MOD = DEPTH * 48;
    for (int it = obid(); it < N_TR + N_MOD; it += gridDim.x) {
        if (it >= N_MOD) {
            const int it2 = it - N_MOD;
            const int l = it2 / (I_IN + I_OUT);
            int r = it2 % (I_IN + I_OUT);
            if (r < I_IN) transpose_item<true>(p.w_in + (size_t)l * DM * PW, PW, wtin + (size_t)l * PW * DM, r / 26, r % 26, scr);
            else { r -= I_IN; transpose_item<false>(p.w_out + (size_t)l * DM * DM, DM, wtout + (size_t)l * DM * DM, r / 8, r % 8, scr); }
        } else {
            const int m = it, l = m / 48, cb = m % 48;
            float* sv = scr;
            float* red = scr + 5 * 1024;
            for (int i = tid; i < 5 * 1024; i += NTHREADS) {
                const int v = i >> 10, k = i & 1023;
                const float cv = (v < 4) ? p.c[v * 1024 + k] : p.c_ctx[k];
                sv[i] = siluf_(cv);
            }
            __syncthreads();
            const float* W = p.w_mod + (size_t)l * DM * 3072 + cb * 64 + lane;
            float a0 = 0, a1 = 0, a2 = 0, a3 = 0, a4 = 0;
#pragma unroll 1
            for (int k0 = wid * 128; k0 < wid * 128 + 128; k0 += 16) {
                float wv[16];
#pragma unroll
                for (int j = 0; j < 16; ++j) wv[j] = W[(size_t)(k0 + j) * 3072];
#pragma unroll
                for (int j = 0; j < 16; ++j) {
                    const int k = k0 + j; const float w = wv[j];
                    a0 += sv[k] * w; a1 += sv[1024 + k] * w; a2 += sv[2048 + k] * w; a3 += sv[3072 + k] * w; a4 += sv[4096 + k] * w;
                }
            }
            red[(wid * 5 + 0) * 64 + lane] = a0; red[(wid * 5 + 1) * 64 + lane] = a1; red[(wid * 5 + 2) * 64 + lane] = a2;
            red[(wid * 5 + 3) * 64 + lane] = a3; red[(wid * 5 + 4) * 64 + lane] = a4;
            __syncthreads();
            if (tid < 320) {
                const int v = tid >> 6, n = tid & 63;
                float s = 0;
#pragma unroll
                for (int w = 0; w < 8; ++w) s += red[(w * 5 + v) * 64 + n];
                s += p.b_mod[l * 3072 + cb * 64 + n];
                ((float*)(p.ws + WS_MOD))[(l * 5 + v) * 3072 + cb * 64 + n] = s;
            }
            __syncthreads();
            if (tid == 0) {
                __builtin_amdgcn_fence(__ATOMIC_RELEASE, "agent");
                __hip_atomic_fetch_add((unsigned*)(p.ws + WS_MODCNT), 1u, __ATOMIC_RELAXED, __HIP_MEMORY_SCOPE_AGENT);
            }
        }
    }
    const int gt = obid() * NTHREADS + tid, gs = gridDim.x * NTHREADS;
    u16* wsbf = (u16*)(p.ws + WS_WSBF);
    for (int i = gt; i < DEPTH * 4 * 128 * 128; i += gs) wsbf[i] = (u16)f2bf(p.w_s[i]);
    float* rope = (float*)(p.ws + WS_ROPE);
    for (int i = gt; i < 128 * 16; i += gs) {
        const int pos = i >> 4, f = i & 15;
        const float invf = exp2f(-(float)f * (13.287712379549449f / 16.0f));
        const float ang = (float)pos * invf;
        const float tr = ang * 0.15915494309189535f;
        const float fr = tr - floorf(tr);
        rope[2 * i] = __builtin_amdgcn_cosf(fr);
        rope[2 * i + 1] = __builtin_amdgcn_sinf(fr);
    }
}

DI const float* mod_ptr(const Params& p, int l, int row) {
    const int v = row < NLAT ? row / SEQ : 4;
    return (const float*)(p.ws + WS_MOD) + (size_t)(l * 5 + v) * 3072;
}
DI void write_h(const Params& p, int l, int row, const f32x4* xv, int lane) {
    float ss = 0;
#pragma unroll
    for (int j = 0; j < 4; ++j) ss += xv[j][0] * xv[j][0] + xv[j][1] * xv[j][1] + xv[j][2] * xv[j][2] + xv[j][3] * xv[j][3];
    ss = wave_sum(ss);
    const float rstd = rsqrtf(ss * (1.f / DM) + 1e-6f);
    const float* md = mod_ptr(p, l, row);
    const float* gp = p.g_pre + l * DM;
    u16* H = (u16*)(p.ws + WS_H) + (size_t)row * DM;
#pragma unroll
    for (int j = 0; j < 4; ++j) {
        const int idx = j * 256 + lane * 4;
        const f32x4 g = *(const f32x4*)(gp + idx), sh = *(const f32x4*)(md + idx), sc = *(const f32x4*)(md + 1024 + idx);
        float o[4];
#pragma unroll
        for (int e = 0; e < 4; ++e) o[e] = xv[j][e] * rstd * g[e] * (1.f + sc[e]) + sh[e];
        u32x2 pk; pk[0] = pk2(o[0], o[1]); pk[1] = pk2(o[2], o[3]);
        *(u32x2*)(H + idx) = pk;
    }
}
DI void phase_prenorm0(const Params& p) {
    const int tid = otid(), lane = tid & 63, gw = obid() * 8 + (tid >> 6), nw = gridDim.x * 8;
    for (int row = gw; row < NROWS; row += nw) {
        const float* xr = row < NLAT ? p.x + (size_t)row * DM : p.ctx + (size_t)(row - NLAT) * DM;
        f32x4 xv[4];
#pragma unroll
        for (int j = 0; j < 4; ++j) xv[j] = *(const f32x4*)(xr + j * 256 + lane * 4);
        write_h(p, 0, row, xv, lane);
    }
}
DI void residual_rows(const Params& p, int l, int r0, int r1) {
    const int tid = otid(), lane = tid & 63;
    const bool last = (l == DEPTH - 1);
    if (r0 >= r1) return;
    const u16* YO = (const u16*)(p.ws + WS_H);
    u16* H = (u16*)(p.ws + WS_H);
    u16* XS = (u16*)(p.ws + WS_XC);
    const bool first = (l == 0);
    const float* modb = (const float*)(p.ws + WS_MOD);
    float gpost[16], gpre[16], gt[16], sh[16], sc[16];
#define RES_V16(DST, SRC) do { _Pragma("unroll") for (int j = 0; j < 2; ++j) { const f32x4 a_ = *(const f32x4*)((SRC) + j * 512 + lane * 8), b_ = *(const f32x4*)((SRC) + j * 512 + lane * 8 + 4); \
        _Pragma("unroll") for (int e = 0; e < 4; ++e) { DST[j * 8 + e] = a_[e]; DST[j * 8 + 4 + e] = b_[e]; } } } while (0)
    RES_V16(gpost, p.g_post + l * DM);
    if (!last) RES_V16(gpre, p.g_pre + (l + 1) * DM);
    else { _Pragma("unroll") for (int e = 0; e < 16; ++e) gpre[e] = 0.f; }
#pragma unroll
    for (int e = 0; e < 16; ++e) { gt[e] = 0.f; sh[e] = 0.f; sc[e] = 0.f; }
    int curv = -1;
    f32x4 xnA[4], xnB[4]; u32x4 xnbA[2], xnbB[2], ynA[2], ynB[2];
#define RES_LOAD(XN, XNB, YN, R) do { const int r_ = (R); \
        if (first) { const float* xr = r_ < NLAT ? p.x + (size_t)r_ * DM : p.ctx + (size_t)(r_ - NLAT) * DM; \
            _Pragma("unroll") for (int j = 0; j < 2; ++j) { XN[2 * j] = *(const f32x4*)(xr + j * 512 + lane * 8); XN[2 * j + 1] = *(const f32x4*)(xr + j * 512 + lane * 8 + 4); } } \
        else { _Pragma("unroll") for (int j = 0; j < 2; ++j) XNB[j] = *(const u32x4*)(XS + (size_t)r_ * DM + j * 512 + lane * 8); } \
        _Pragma("unroll") for (int j = 0; j < 2; ++j) YN[j] = *(const u32x4*)(YO + (size_t)r_ * DM + j * 512 + lane * 8); } while (0)
    auto proc = [&](f32x4 (&xn)[4], u32x4 (&xnb)[2], u32x4 (&yn)[2], const int row, const int rnext) __attribute__((always_inline)) {
        float xv[16], yv[16];
#pragma unroll
        for (int j = 0; j < 2; ++j) {
            if (first) { _Pragma("unroll") for (int e = 0; e < 4; ++e) { xv[j * 8 + e] = xn[2 * j][e]; xv[j * 8 + 4 + e] = xn[2 * j + 1][e]; } }
            else unpack8(xnb[j], xv + j * 8);
            unpack8(yn[j], yv + j * 8);
        }
        if (rnext < r1) RES_LOAD(xn, xnb, yn, rnext);
        const int v = row < NLAT ? row / SEQ : 4;
        if (v != curv) {
            curv = v;
            RES_V16(gt, modb + (size_t)(l * 5 + v) * 3072 + 2048);
            if (!last) { RES_V16(sh, modb + (size_t)((l + 1) * 5 + v) * 3072); RES_V16(sc, modb + (size_t)((l + 1) * 5 + v) * 3072 + 1024); }
        }
        float ss = 0.f;
#pragma unroll
        for (int e = 0; e < 16; ++e) ss += yv[e] * yv[e];
        ss = wave_sum(ss);
        const float rstd = rsqrtf(ss * (1.f / DM) + 1e-6f);
        float s2 = 0.f;
#pragma unroll
        for (int e = 0; e < 16; ++e) { xv[e] = xv[e] + gt[e] * (yv[e] * rstd * gpost[e]); s2 += xv[e] * xv[e]; }
        if (last) {
            float* xw = p.out + (size_t)row * DM;
#pragma unroll
            for (int j = 0; j < 2; ++j) {
                *(f32x4*)(xw + j * 512 + lane * 8) = (f32x4){xv[j * 8], xv[j * 8 + 1], xv[j * 8 + 2], xv[j * 8 + 3]};
                *(f32x4*)(xw + j * 512 + lane * 8 + 4) = (f32x4){xv[j * 8 + 4], xv[j * 8 + 5], xv[j * 8 + 6], xv[j * 8 + 7]};
            }
        } else {
#pragma unroll
            for (int j = 0; j < 2; ++j) {
                u32x4 pk; pk[0] = pk2(xv[j * 8], xv[j * 8 + 1]); pk[1] = pk2(xv[j * 8 + 2], xv[j * 8 + 3]); pk[2] = pk2(xv[j * 8 + 4], xv[j * 8 + 5]); pk[3] = pk2(xv[j * 8 + 6], xv[j * 8 + 7]);
                *(u32x4*)(XS + (size_t)row * DM + j * 512 + lane * 8) = pk;
            }
            s2 = wave_sum(s2);
            const float rs2 = rsqrtf(s2 * (1.f / DM) + 1e-6f);
#pragma unroll
            for (int j = 0; j < 2; ++j) {
                float o[8];
#pragma unroll
                for (int e = 0; e < 8; ++e) o[e] = xv[j * 8 + e] * rs2 * gpre[j * 8 + e] * (1.f + sc[j * 8 + e]) + sh[j * 8 + e];
                u32x4 pk; pk[0] = pk2(o[0], o[1]); pk[1] = pk2(o[2], o[3]); pk[2] = pk2(o[4], o[5]); pk[3] = pk2(o[6], o[7]);
                *(u32x4*)(H + (size_t)row * DM + j * 512 + lane * 8) = pk;
            }
        }
    };
    RES_LOAD(xnA, xnbA, ynA, r0);
    if (r0 + 1 < r1) RES_LOAD(xnB, xnbB, ynB, r0 + 1);
#pragma unroll 1
    for (int row = r0; row < r1; row += 2) {
        proc(xnA, xnbA, ynA, row, row + 2);
        if (row + 1 < r1) proc(xnB, xnbB, ynB, row + 1, row + 3);
    }
#undef RES_LOAD
#undef RES_V16
}

namespace pg8 {
#define PG8_LAS __attribute__((address_space(3)))
typedef unsigned short bf16_t;
typedef short bf16x8 __attribute__((ext_vector_type(8)));
typedef float f32x4 __attribute__((ext_vector_type(4)));
typedef unsigned u32x4 __attribute__((ext_vector_type(4)));
constexpr int BM = 256, BK = 64, HALF = 128, HTB = HALF * BK * 2  , STAGE_BYTES = 8 * HTB, NXCD = 8, WGM = 4;

__host__ __device__ __forceinline__ int lds_byte(int r, int c) { const int st = (r >> 4) * 2 + (c >> 5), rr = r & 15, cc = c & 31, ob = rr * 64 + cc * 2; return st * 1024 + (ob ^ (((ob >> 9) & 1) << 5)); }
__host__ __device__ __forceinline__ void stage_rc(int b, int& R, int& C) { const int st = b / 1024, sb = b % 1024, swz = sb ^ (((sb >> 9) & 1) << 5); R = (st >> 1) * 16 + swz / 64; C = (st & 1) * 32 + (swz % 64) / 2; }
__host__ __device__ __forceinline__ int perm32(int rho) { const int n = rho >> 4, i = rho & 15; return 8 * (i >> 2) + 4 * n + (i & 3); }

struct Unit { int pm, pn; };
struct Gemm { const bf16_t* A; const bf16_t* Bt; int M, N, K; };

struct StaticOrder {
    int nM, nN, nwg, G, c;
    __host__ __device__ void init(int M, int N, int G_, int c_) { nM = M / BM; nN = N / BM; nwg = nM * nN; G = G_; c = c_; }
    __host__ __device__ bool next(int i, Unit& u) const {
        const long L = (long)i * G + c; if (L >= nwg) return false;
        int wgid = (int)L; { const int q = nwg / NXCD, r = nwg % NXCD, xcd = wgid % NXCD, off = wgid / NXCD; wgid = (xcd < r ? xcd * (q + 1) : r * (q + 1) + (xcd - r) * q) + off; }
        const int nig = WGM * nN, gid = wgid / nig, fm = gid * WGM, gsz = (nM - fm) < WGM ? (nM - fm) : WGM;
        u.pm = fm + ((wgid % nig) % gsz); u.pn = (wgid % nig) / gsz; return true;
    }
    __device__ __forceinline__ void a_ready(const Unit&) const {}
    __device__ __forceinline__ void done(const Unit&) const {}
};
struct EpiPlain {
    static constexpr bool PERM = true, AFTER_DRAIN = false;
    u16* O; int ldc;
    __device__ __forceinline__ void operator()(const f32x4 (&acc)[2][2][4][2], const Unit& u, int wr, int wc, int fr, int fq) const {
        const int row0 = u.pm * BM + wr * 64 + fr, col0 = u.pn * BM + wc * 32 + 8 * fq;
#pragma unroll
        for (int ai = 0; ai < 2; ++ai)
#pragma unroll
            for (int m = 0; m < 4; ++m) {
                u16* rowp = O + (size_t)(row0 + ai * HALF + m * 16) * ldc + col0;
#pragma unroll
                for (int bj = 0; bj < 2; ++bj) {
                    const f32x4 v0 = acc[ai][bj][m][0], v1 = acc[ai][bj][m][1];
                    u32x4 w; w[0] = pk2(v0[0], v0[1]); w[1] = pk2(v0[2], v0[3]); w[2] = pk2(v1[0], v1[1]); w[3] = pk2(v1[2], v1[3]);
                    *(u32x4*)(rowp + bj * HALF) = w;
                }
            }
    }
};
struct EpiInProj {
    static constexpr bool PERM = true, AFTER_DRAIN = false;
    u16* P; u16* Q; u16* K; u16* Vt; const float* qg; const float* kg; const float* rope; bool last;
    __device__ __forceinline__ void operator()(const f32x4 (&acc)[2][2][4][2], const Unit& u, int wr, int wc, int fr, int fq) const {
        if (u.pn != 10 && u.pn != 11) {
            const int pn = u.pn;
            const int row0 = u.pm * BM + wr * 64 + fr;
            if (pn == 6 || pn == 9 || pn == 12) {
                const int seg = pn == 6 ? O_SBG : (pn == 9 ? O_CV : O_SDG);
                const bool act = pn != 9;
#pragma unroll
                for (int ai = 0; ai < 2; ++ai)
#pragma unroll
                    for (int m = 0; m < 4; ++m) {
                        u16* rowp = P + (size_t)(row0 + ai * HALF + m * 16) * PWO + seg + wc * 32 + 8 * fq;
#pragma unroll
                        for (int bj = 0; bj < 2; ++bj) {
                            f32x4 v0 = acc[ai][bj][m][0], v1 = acc[ai][bj][m][1];
                            if (act) {
#pragma unroll
                                for (int e = 0; e < 4; ++e) { v0[e] = siluf_(v0[e]); v1[e] = siluf_(v1[e]); }
                            }
                            u32x4 w; w[0] = pk2(v0[0], v0[1]); w[1] = pk2(v0[2], v0[3]); w[2] = pk2(v1[0], v1[1]); w[3] = pk2(v1[2], v1[3]);
                            *(u32x4*)(rowp + bj * HALF) = w;
                        }
                    }
                return;
            }
            const int seg = pn < 2 ? O_CX : (pn < 4 ? O_ABG : (pn < 6 ? O_Z : O_UG));
            const int half = pn < 6 ? (pn & 1) : ((pn - 7) & 1);
            const int op = pn < 2 ? 0 : ((pn == 4 || pn == 5) ? 2 : 1);
#pragma unroll
            for (int ai = 0; ai < 2; ++ai)
#pragma unroll
                for (int m = 0; m < 4; ++m) {
                    float o[8];
#pragma unroll
                    for (int n = 0; n < 2; ++n)
#pragma unroll
                        for (int e = 0; e < 4; ++e) {
                            const float x = acc[ai][0][m][n][e], y = acc[ai][1][m][n][e];
                            o[4 * n + e] = op == 0 ? x * y : (op == 1 ? x * siluf_(y) : x * sigmoidf_(y));
                        }
                    u32x4 w; w[0] = pk2(o[0], o[1]); w[1] = pk2(o[2], o[3]); w[2] = pk2(o[4], o[5]); w[3] = pk2(o[6], o[7]);
                    *(u32x4*)(P + (size_t)(row0 + ai * HALF + m * 16) * PWO + seg + half * 128 + wc * 32 + 8 * fq) = w;
                }
            return;
        }
        const int pm = u.pm;
        const bool lat = pm < NLAT / 256;
        const int b = lat ? (pm >> 5) : (pm - NLAT / 256);
        const int seq0 = lat ? b * SEQ : NLAT + b * CTX;
        const int rowb = pm * BM + wr * 64 + fr;
        if (u.pn == 11 && wc >= 2) {
            const int head = wc - 2;
            const int pfr = (fr & 3) | (((fr >> 3) & 1) << 2) | (((fr >> 2) & 1) << 3);
#pragma unroll
            for (int ai = 0; ai < 2; ++ai)
#pragma unroll
                for (int m = 0; m < 4; ++m) {
                    const int pos = rowb + ai * HALF + m * 16 - seq0 - fr;
                    const int tp = (lat ? CTX + pos : pos) + pfr;
#pragma unroll
                    for (int bj = 0; bj < 2; ++bj)
#pragma unroll
                        for (int n = 0; n < 2; ++n)
#pragma unroll
                            for (int e = 0; e < 4; ++e) {
                                const int d = 32 * bj + 16 * n + 4 * fq + e;
                                Vt[((size_t)(b * 2 + head) * 64 + d) * TKV + tp] = (u16)f2bf(acc[ai][bj][m][n][e]);
                            }
                }
            return;
        }
        const bool isq = (u.pn == 10);
        if (isq && last && !lat) return;
        const float* gp = isq ? qg : kg;
        const int head = wc;
        f32x4 g[2][2];
#pragma unroll
        for (int bj = 0; bj < 2; ++bj)
#pragma unroll
            for (int n = 0; n < 2; ++n) g[bj][n] = *(const f32x4*)(gp + 32 * bj + 16 * n + 4 * fq);
        const float osc = isq ? QSCALE : 1.f;
        u16* dst = isq ? Q + (size_t)(b * 4 + head) * TKV * 64 : K + (size_t)(b * 2 + head) * TKV * 64;
#pragma unroll
        for (int ai = 0; ai < 2; ++ai)
#pragma unroll
            for (int m = 0; m < 4; ++m) {
                const int pos = rowb + ai * HALF + m * 16 - seq0;
                const int tp = lat ? CTX + pos : pos;
                float ss = 0.f;
#pragma unroll
                for (int bj = 0; bj < 2; ++bj)
#pragma unroll
                    for (int n = 0; n < 2; ++n)
#pragma unroll
                        for (int e = 0; e < 4; ++e) ss += acc[ai][bj][m][n][e] * acc[ai][bj][m][n][e];
                ss += __shfl_xor(ss, 16); ss += __shfl_xor(ss, 32);
                const float rstd = rsqrtf(ss * (1.f / 64) + 1e-6f) ;
#pragma unroll
                for (int bj = 0; bj < 2; ++bj) {
                    f32x4 y1 = acc[ai][bj][m][0] * rstd * g[bj][0], y2 = acc[ai][bj][m][1] * rstd * g[bj][1];
                    f32x4 o1 = y1, o2 = y2;
                    if (lat) {
                        const int pp = bj == 0 ? (pos >> 6) : (pos & 63);
                        const f32x4 t0 = *(const f32x4*)(rope + (pp * 16 + 4 * fq) * 2), t1 = *(const f32x4*)(rope + (pp * 16 + 4 * fq) * 2 + 4);
                        const f32x4 cs = {t0[0], t0[2], t1[0], t1[2]}, sn = {t0[1], t0[3], t1[1], t1[3]};
                        o1 = y1 * cs - y2 * sn; o2 = y2 * cs + y1 * sn;
                    }
                    o1 = o1 * osc; o2 = o2 * osc;
                    u32x2 w1, w2; w1[0] = pk2(o1[0], o1[1]); w1[1] = pk2(o1[2], o1[3]); w2[0] = pk2(o2[0], o2[1]); w2[1] = pk2(o2[2], o2[3]);
                    *(u32x2*)(dst + (size_t)tp * 64 + 32 * bj + 4 * fq) = w1;
                    *(u32x2*)(dst + (size_t)tp * 64 + 32 * bj + 16 + 4 * fq) = w2;
                }
            }
    }
};

template <class Epi, class Sched, bool ALIGN_EPI = false, bool SP2 = false>
__device__ __forceinline__ void gemm_phase(PG8_LAS unsigned char* lds, const Gemm g, const Sched& S, const Epi& E) {
    const int tid = otid(), wid = __builtin_amdgcn_readfirstlane(tid >> 6), lane = tid & 63, wr = wid >> 2, wc = wid & 3, fr = lane & 15, fq = lane >> 4;
    const int K = g.K, nt = K / BK;
    unsigned voffA[2], voffB[2];
#pragma unroll
    for (int i = 0; i < 2; ++i) { int R, C; stage_rc(tid * 16 + i * 8192, R, C); const int Rb = Epi::PERM ? ((R & ~31) + perm32(R & 31)) : R;
        voffA[i] = (unsigned)(R * K + C) * 2u; voffB[i] = (unsigned)(Rb * K + C) * 2u; }
    const size_t kstep = (size_t)(BK * 2);
    const size_t hstep = (size_t)HALF * K * 2;
    const size_t tstep = 2 * hstep;
    const unsigned ldsw = (unsigned)wid * 1024u;
    const int aoff = lds_byte(wr * 64 + fr, fq * 8), boff = lds_byte(wc * 32 + fr, fq * 8);
#define PG8_SA(b, h) (((b) * 2 + (h)) * HTB)
#define PG8_SB(b, h) ((4 + (b) * 2 + (h)) * HTB)
#define PG8_STAGE(bufoff, gbase, voff) do { _Pragma("unroll") for (int _i = 0; _i < 2; ++_i) \
        __builtin_amdgcn_global_load_lds((const unsigned*)((const char*)(gbase) + (voff)[_i]), (PG8_LAS unsigned*)(lds + (bufoff) + ldsw + _i * 8192), 16, 0, 0); } while (0)
#define PG8_LDA(dst, b, h) do { _Pragma("unroll") for (int m = 0; m < 4; ++m) _Pragma("unroll") for (int k = 0; k < 2; ++k) dst[m][k] = *(const PG8_LAS bf16x8*)(lds + PG8_SA(b, h) + aoff + m * 2048 + k * 1024); } while (0)
#define PG8_LDB(dst, b, h) do { _Pragma("unroll") for (int n = 0; n < 2; ++n) _Pragma("unroll") for (int k = 0; k < 2; ++k) dst[n][k] = *(const PG8_LAS bf16x8*)(lds + PG8_SB(b, h) + boff + n * 2048 + k * 1024); } while (0)
#define PG8_MMA(ai, bj, At, Bt) do { __builtin_amdgcn_s_setprio(1); _Pragma("unroll") for (int m = 0; m < 4; ++m) _Pragma("unroll") for (int n = 0; n < 2; ++n) _Pragma("unroll") for (int k = 0; k < 2; ++k) \
        acc[ai][bj][m][n] = __builtin_amdgcn_mfma_f32_16x16x32_bf16(Bt[n][k], At[m][k], acc[ai][bj][m][n], 0, 0, 0); __builtin_amdgcn_s_setprio(0); } while (0)
#define PG8_WAIT_V(n) asm volatile("s_waitcnt vmcnt(" #n ")" ::: "memory")
#define PG8_WAIT_L(n) asm volatile("s_waitcnt lgkmcnt(" #n ")" ::: "memory")
#define PG8_BAR __builtin_amdgcn_s_barrier()
#define PG8_SCHED __builtin_amdgcn_sched_barrier(0)
    Unit cur, nxt; int ui = 0;
    if (!S.next(0, cur)) return;
    f32x4 acc[2][2][4][2];
#pragma unroll
    for (int a = 0; a < 2; ++a)
#pragma unroll
        for (int b = 0; b < 2; ++b)
#pragma unroll
            for (int m = 0; m < 4; ++m)
#pragma unroll
                for (int n = 0; n < 2; ++n) acc[a][b][m][n] = (f32x4){0.f, 0.f, 0.f, 0.f};
    bf16x8 At[4][2], B0[2][2], B1[2][2];
    const char* cA = (const char*)g.A + (size_t)cur.pm * tstep; const char* cB = (const char*)g.Bt + (size_t)cur.pn * tstep;
    S.a_ready(cur);
    if constexpr (SP2) {
        PG8_STAGE(PG8_SB(0, 0), cB, voffB); PG8_STAGE(PG8_SB(0, 1), cB + hstep, voffB); PG8_STAGE(PG8_SA(0, 0), cA, voffA); PG8_STAGE(PG8_SA(0, 1), cA + hstep, voffA);
        if (wr == 1) PG8_BAR;
        PG8_WAIT_V(2); PG8_BAR;
        PG8_STAGE(PG8_SB(1, 0), cB + kstep, voffB); PG8_STAGE(PG8_SA(1, 0), cA + kstep, voffA); PG8_STAGE(PG8_SB(1, 1), cB + hstep + kstep, voffB);
        PG8_WAIT_V(6); PG8_BAR;
    } else {
        PG8_STAGE(PG8_SB(0, 0), cB, voffB); PG8_STAGE(PG8_SA(0, 0), cA, voffA); PG8_STAGE(PG8_SB(0, 1), cB + hstep, voffB); PG8_STAGE(PG8_SA(0, 1), cA + hstep, voffA);
        if (wr == 1) PG8_BAR;
        PG8_WAIT_V(4); PG8_BAR;
        PG8_STAGE(PG8_SB(1, 0), cB + kstep, voffB); PG8_STAGE(PG8_SA(1, 0), cA + kstep, voffA); PG8_STAGE(PG8_SB(1, 1), cB + hstep + kstep, voffB);
        PG8_WAIT_V(6); PG8_BAR;
    }
    for (;;) {
        const bool has_next = S.next(ui + 1, nxt);
        const char* nA = has_next ? (const char*)g.A + (size_t)nxt.pm * tstep : cA; const char* nB = has_next ? (const char*)g.Bt + (size_t)nxt.pn * tstep : cB;
        for (int t = 0; t < nt; t += 2) {
            const bool last = (t == nt - 2);
            const char* a1 = cA + (size_t)(t + 1) * kstep;
            const char* a2 = last ? nA : cA + (size_t)(t + 2) * kstep; const char* b2 = last ? nB : cB + (size_t)(t + 2) * kstep;
            const char* a3 = a2 + kstep; const char* b3 = b2 + kstep;
            if (last && has_next) S.a_ready(nxt);
            if constexpr (SP2) {
            PG8_LDB(B0, 0, 0); PG8_LDB(B1, 0, 1); PG8_SCHED; PG8_LDA(At, 0, 0); PG8_STAGE(PG8_SA(1, 1), a1 + hstep, voffA);
            PG8_WAIT_V(8); PG8_WAIT_L(0); PG8_BAR; PG8_MMA(0, 0, At, B0); PG8_MMA(0, 1, At, B1); PG8_BAR; PG8_SCHED;
            PG8_LDA(At, 0, 1); PG8_STAGE(PG8_SB(0, 0), b2, voffB); PG8_STAGE(PG8_SB(0, 1), b2 + hstep, voffB); PG8_STAGE(PG8_SA(0, 0), a2, voffA);
            PG8_WAIT_V(8); PG8_WAIT_L(0); PG8_BAR; PG8_MMA(1, 0, At, B0); PG8_MMA(1, 1, At, B1); PG8_BAR; PG8_SCHED;
            PG8_LDB(B0, 1, 0); PG8_LDB(B1, 1, 1); PG8_SCHED; PG8_LDA(At, 1, 0); PG8_STAGE(PG8_SA(0, 1), a2 + hstep, voffA);
            PG8_WAIT_V(8); PG8_WAIT_L(0); PG8_BAR; PG8_MMA(0, 0, At, B0); PG8_MMA(0, 1, At, B1); PG8_BAR; PG8_SCHED;
            PG8_LDA(At, 1, 1); PG8_STAGE(PG8_SB(1, 0), b3, voffB); PG8_STAGE(PG8_SB(1, 1), b3 + hstep, voffB); PG8_STAGE(PG8_SA(1, 0), a3, voffA);
            PG8_WAIT_V(8); PG8_WAIT_L(0); PG8_BAR; PG8_MMA(1, 0, At, B0); PG8_MMA(1, 1, At, B1); PG8_BAR; PG8_SCHED;
            } else {
            PG8_LDB(B0, 0, 0); PG8_SCHED; PG8_LDA(At, 0, 0); PG8_STAGE(PG8_SA(1, 1), a1 + hstep, voffA);
            PG8_WAIT_L(8); PG8_BAR; PG8_WAIT_L(0); PG8_MMA(0, 0, At, B0); PG8_BAR; PG8_SCHED;
            PG8_LDB(B1, 0, 1); PG8_STAGE(PG8_SB(0, 0), b2, voffB);
            PG8_BAR; PG8_WAIT_L(0); PG8_MMA(0, 1, At, B1); PG8_BAR;
            PG8_LDA(At, 0, 1); PG8_STAGE(PG8_SA(0, 0), a2, voffA);
            PG8_BAR; PG8_WAIT_L(0); PG8_MMA(1, 0, At, B0); PG8_BAR; PG8_SCHED;
            PG8_STAGE(PG8_SB(0, 1), b2 + hstep, voffB);
            PG8_WAIT_V(6); PG8_BAR; PG8_MMA(1, 1, At, B1); PG8_BAR;
            PG8_LDB(B0, 1, 0); PG8_SCHED; PG8_LDA(At, 1, 0); PG8_STAGE(PG8_SA(0, 1), a2 + hstep, voffA);
            PG8_WAIT_L(8); PG8_BAR; PG8_WAIT_L(0); PG8_MMA(0, 0, At, B0); PG8_BAR; PG8_SCHED;
            PG8_LDB(B1, 1, 1); PG8_STAGE(PG8_SB(1, 0), b3, voffB);
            PG8_BAR; PG8_WAIT_L(0); PG8_MMA(0, 1, At, B1); PG8_BAR;
            PG8_LDA(At, 1, 1); PG8_STAGE(PG8_SA(1, 0), a3, voffA);
            PG8_BAR; PG8_WAIT_L(0); PG8_MMA(1, 0, At, B0); PG8_BAR; PG8_SCHED;
            PG8_STAGE(PG8_SB(1, 1), b3 + hstep, voffB);
            PG8_WAIT_V(6); PG8_BAR; PG8_MMA(1, 1, At, B1); PG8_BAR;
            }
        }
        if constexpr (ALIGN_EPI) { if (wr == 0) PG8_BAR; }
        if constexpr (!Epi::AFTER_DRAIN) { E(acc, cur, wr, wc, fr, fq); S.done(cur); }
        if (!has_next) break;
#pragma unroll
        for (int a = 0; a < 2; ++a)
#pragma unroll
            for (int b = 0; b < 2; ++b)
#pragma unroll
                for (int m = 0; m < 4; ++m)
#pragma unroll
                    for (int n = 0; n < 2; ++n) acc[a][b][m][n] = (f32x4){0.f, 0.f, 0.f, 0.f};
        cur = nxt; cA = nA; cB = nB; ++ui;
        if constexpr (ALIGN_EPI) { if (wr == 1) PG8_BAR; }
    }
    PG8_WAIT_V(0);
    if constexpr (!ALIGN_EPI) { if (wr == 0) PG8_BAR; }
    PG8_BAR;
    if constexpr (Epi::AFTER_DRAIN) { E.fused(acc, cur, wr, wc, fr, fq, lds, wid, lane); S.done(cur); }
#undef PG8_SA
#undef PG8_SB
#undef PG8_STAGE
#undef PG8_LDA
#undef PG8_LDB
#undef PG8_MMA
#undef PG8_WAIT_V
#undef PG8_WAIT_L
#undef PG8_BAR
#undef PG8_SCHED
}
}

DI void tok_item(const Params& p, int l, int item, unsigned char* lds) {
    const int tid = otid(), lane = tid & 63, wid = tid >> 6;
    const int R0 = item * 64;
    const bool lat = R0 < NLAT;
    int seq_start, seq_end;
    if (lat) { const int b = R0 / SEQ; seq_start = b * SEQ; seq_end = seq_start + SEQ; }
    else { const int b = (R0 - NLAT) / CTX; seq_start = NLAT + b * CTX; seq_end = seq_start + CTX; }
    const u16* P = (const u16*)(p.ws + WS_P);
    u16* YM = (u16*)(p.ws + WS_YMIX);
    u16* zl = (u16*)lds;
    float* cvo = (float*)(lds + 48128);
    const u32x4 zero4 = {0u, 0u, 0u, 0u};
    u32x4 zv[6];
#pragma unroll
    for (int j = 0; j < 6; ++j) {
        const int ci = j * NTHREADS + tid, zr = ci >> 5, c8 = (ci & 31) * 8, row = R0 - 15 + zr;
        zv[j] = (ci < 94 * 32 && row >= seq_start && row < seq_end) ? *(const u32x4*)(P + (size_t)row * PWO + O_Z + c8) : zero4;
    }
    const int cp = tid & 127, qt = tid >> 7;
    float w0[31], w1[31];
    {
        const float* wb = p.conv_b + (size_t)l * 31 * 256 + cp * 2;
#pragma unroll
        for (int k = 0; k < 31; ++k) { const f32x2_t w2 = *(const f32x2_t*)(wb + k * 256); w0[k] = w2[0]; w1[k] = w2[1]; }
    }
    const float bias0 = p.conv_b_bias[l * 256 + cp * 2], bias1 = p.conv_b_bias[l * 256 + cp * 2 + 1];
    u32x4 cv[4][3], bv[4];
#pragma unroll
    for (int j = 0; j < 4; ++j) {
        const int ci = j * NTHREADS + tid, tl = ci >> 5, c8 = (ci & 31) * 8, row = R0 + tl;
#pragma unroll
        for (int k = 0; k < 3; ++k) {
            const int rr = row + k - 1;
            cv[j][k] = (rr >= seq_start && rr < seq_end) ? *(const u32x4*)(P + (size_t)rr * PWO + O_CX + c8) : zero4;
        }
        bv[j] = *(const u32x4*)(P + (size_t)row * PWO + O_ABG + c8);
    }
    const int sub = lane & 15, t4 = lane >> 4, ch = sub * 16;
    u32x4 gr[2][2];
#pragma unroll
    for (int i = 0; i < 2; ++i) {
        const int row = R0 + wid * 8 + i * 4 + t4;
        gr[i][0] = *(const u32x4*)(P + (size_t)row * PWO + O_SBG + ch);
        gr[i][1] = *(const u32x4*)(P + (size_t)row * PWO + O_SBG + ch + 8);
    }
#pragma unroll
    for (int j = 0; j < 6; ++j) {
        const int ci = j * NTHREADS + tid, zr = ci >> 5, c8 = (ci & 31) * 8;
        if (ci < 94 * 32) *(u32x4*)(zl + zr * 256 + c8) = zv[j];
    }
    __syncthreads();
    {
#pragma unroll 1
        for (int ps = 0; ps < 2; ++ps) {
            float a0[8], a1[8];
#pragma unroll
            for (int o = 0; o < 8; ++o) { a0[o] = bias0; a1[o] = bias1; }
            const u16* zb = zl + (qt * 16 + ps * 8) * 256 + cp * 2;
#pragma unroll
            for (int i = 0; i < 38; ++i) {
                const unsigned zz = *(const unsigned*)(zb + i * 256);
                const float z0 = bflo(zz), z1 = bfhi(zz);
#pragma unroll
                for (int o = 0; o < 8; ++o) {
                    const int k = i - o;
                    if (k >= 0 && k < 31) { a0[o] += z0 * w0[k]; a1[o] += z1 * w1[k]; }
                }
            }
#pragma unroll
            for (int o = 0; o < 8; ++o) { cvo[(qt * 16 + ps * 8 + o) * 256 + cp * 2] = a0[o]; cvo[(qt * 16 + ps * 8 + o) * 256 + cp * 2 + 1] = a1[o]; }
        }
    }
    {
        const float* wa = p.conv_a + (size_t)l * 3 * 256;
#pragma unroll
        for (int j = 0; j < 4; ++j) {
            const int ci = j * NTHREADS + tid, tl = ci >> 5, c8 = (ci & 31) * 8, row = R0 + tl;
            float acc[8];
#pragma unroll
            for (int e = 0; e < 8; ++e) acc[e] = 0.f;
#pragma unroll
            for (int k = 0; k < 3; ++k) {
                float cf[8]; unpack8(cv[j][k], cf);
                const f32x4 wk0 = *(const f32x4*)(wa + k * 256 + c8), wk1 = *(const f32x4*)(wa + k * 256 + c8 + 4);
#pragma unroll
                for (int e = 0; e < 4; ++e) { acc[e] += cf[e] * wk0[e]; acc[4 + e] += cf[4 + e] * wk1[e]; }
            }
            float bf[8]; unpack8(bv[j], bf);
            u32x4 o;
#pragma unroll
            for (int e = 0; e < 4; ++e) o[e] = pk2(bf[2 * e] * acc[2 * e], bf[2 * e + 1] * acc[2 * e + 1]);
            *(u32x4*)(YM + (size_t)row * DM + c8) = o;
        }
    }
    __syncthreads();
    {
        const float* lg = p.conf_ln_g + l * 256 + ch;
        const float* lb = p.conf_ln_b + l * 256 + ch;
#pragma unroll
        for (int i = 0; i < 2; ++i) {
            const int tl = wid * 8 + i * 4 + t4, row = R0 + tl;
            float v[16];
#pragma unroll
            for (int q = 0; q < 4; ++q) { const f32x4 t = *(const f32x4*)(cvo + tl * 256 + ch + q * 4); v[4 * q] = t[0]; v[4 * q + 1] = t[1]; v[4 * q + 2] = t[2]; v[4 * q + 3] = t[3]; }
            float sm = 0.f;
#pragma unroll
            for (int e = 0; e < 16; ++e) sm += v[e];
            sm += __shfl_xor(sm, 1); sm += __shfl_xor(sm, 2); sm += __shfl_xor(sm, 4); sm += __shfl_xor(sm, 8);
            const float mu = sm * (1.f / 256);
            float sq = 0.f;
#pragma unroll
            for (int e = 0; e < 16; ++e) { v[e] -= mu; sq += v[e] * v[e]; }
            sq += __shfl_xor(sq, 1); sq += __shfl_xor(sq, 2); sq += __shfl_xor(sq, 4); sq += __shfl_xor(sq, 8);
            const float rstd = rsqrtf(sq * (1.f / 256) + 1e-5f);
            float g[16]; unpack8(gr[i][0], g); unpack8(gr[i][1], g + 8);
            u32x4 o[2];
#pragma unroll
            for (int e = 0; e < 8; ++e) {
                const float y0 = v[2 * e] * rstd * lg[2 * e] + lb[2 * e], y1 = v[2 * e + 1] * rstd * lg[2 * e + 1] + lb[2 * e + 1];
                o[e >> 2][e & 3] = pk2(siluf_(y0) * g[2 * e], siluf_(y1) * g[2 * e + 1]);
            }
            *(u32x4*)(YM + (size_t)row * DM + 256 + ch) = o[0];
            *(u32x4*)(YM + (size_t)row * DM + 256 + ch + 8) = o[1];
        }
    }
    __syncthreads();
}

DI void chunk_item(const Params& p, int l, int item, unsigned char* lds) {
    const int tid = otid(), lane = tid & 63, wid = tid >> 6, r = lane & 31, h = lane >> 5;
    const int R0 = item * 128;
    const u16* P = (const u16*)(p.ws + WS_P);
    u16* YM = (u16*)(p.ws + WS_YMIX);
    unsigned char* vt = lds;
    float* part = (float*)(lds + 256 * 272);
    unsigned char* dl = lds + 256 * 272 + 4096;
    {
        const int g = tid >> 7, j = tid & 127;
        const u16* src = P + (size_t)(R0 + j) * PWO + O_CV + g * 64;
        float x[64];
#pragma unroll
        for (int i = 0; i < 8; ++i) { const u32x4 v = *(const u32x4*)(src + i * 8); unpack8(v, x + i * 8); }
        float s = 0, s2 = 0;
#pragma unroll
        for (int i = 0; i < 64; ++i) { s += x[i]; s2 += x[i] * x[i]; }
        part[(g * 128 + j) * 2] = s; part[(g * 128 + j) * 2 + 1] = s2;
        __syncthreads();
        float ts = 0, ts2 = 0;
#pragma unroll
        for (int gg = 0; gg < 4; ++gg) { ts += part[(gg * 128 + j) * 2]; ts2 += part[(gg * 128 + j) * 2 + 1]; }
        const float mu = ts * (1.f / 256);
        const float var = fmaxf(ts2 * (1.f / 256) - mu * mu, 0.f);
        const float rstd = rsqrtf(var + 1e-5f);
        const float* lg = p.sgu_ln_g + l * 256 + g * 64;
        const float* lb = p.sgu_ln_b + l * 256 + g * 64;
#pragma unroll
        for (int i = 0; i < 64; ++i) {
            const float y = (x[i] - mu) * rstd * lg[i] + lb[i];
            *(u16*)(vt + (g * 64 + i) * 272 + j * 2) = (u16)f2bf(y);
        }
    }
    __syncthreads();
    {
        const int g = wid >> 1, half = wid & 1;
        const u16* W = (const u16*)(p.ws + WS_WSBF) + (size_t)(l * 4 + g) * 128 * 128;
        bf16x8 wf[2][8];
#pragma unroll
        for (int ib = 0; ib < 2; ++ib)
#pragma unroll
            for (int s = 0; s < 8; ++s) wf[ib][s] = *(const bf16x8*)(W + ((half * 2 + ib) * 32 + r) * 128 + 16 * s + 8 * h);
        f32x16 acc[2][2];
#pragma unroll
        for (int ib = 0; ib < 2; ++ib)
#pragma unroll
            for (int cb = 0; cb < 2; ++cb)
#pragma unroll
                for (int e = 0; e < 16; ++e) acc[ib][cb][e] = 0.f;
#pragma unroll
        for (int cb = 0; cb < 2; ++cb)
#pragma unroll
            for (int s = 0; s < 8; ++s) {
                const bf16x8 vf = *(const bf16x8*)(vt + (g * 64 + cb * 32 + r) * 272 + (16 * s + 8 * h) * 2);
#pragma unroll
                for (int ib = 0; ib < 2; ++ib) acc[ib][cb] = MFMA32(vf, wf[ib][s], acc[ib][cb]);
            }
        const float* bs = p.b_s + (l * 4 + g) * 128;
#pragma unroll
        for (int ib = 0; ib < 2; ++ib) {
            const int i = (half * 2 + ib) * 32 + r;
            const float bias = bs[i];
#pragma unroll
            for (int cb = 0; cb < 2; ++cb)
#pragma unroll
                for (int q = 0; q < 4; ++q) {
                    u32x2 pk;
                    pk[0] = pk2(acc[ib][cb][4 * q] + bias, acc[ib][cb][4 * q + 1] + bias);
                    pk[1] = pk2(acc[ib][cb][4 * q + 2] + bias, acc[ib][cb][4 * q + 3] + bias);
                    *(u32x2*)(dl + i * 520 + (g * 64 + cb * 32 + 8 * q + 4 * h) * 2) = pk;
                }
        }
    }
    __syncthreads();
#pragma unroll 1
    for (int base = 0; base < 128 * 32; base += 4 * NTHREADS) {
        u32x4 uv[4];
#pragma unroll
        for (int j = 0; j < 4; ++j) {
            const int ci = base + j * NTHREADS + tid, i = ci >> 5, c8 = (ci & 31) * 8;
            uv[j] = *(const u32x4*)(P + (size_t)(R0 + i) * PWO + O_UG + c8);
        }
#pragma unroll
        for (int j = 0; j < 4; ++j) {
            const int ci = base + j * NTHREADS + tid, i = ci >> 5, c8 = (ci & 31) * 8;
            const u32x2 d0 = *(const u32x2*)(dl + i * 520 + c8 * 2), d1 = *(const u32x2*)(dl + i * 520 + c8 * 2 + 8);
            u32x4 dv; dv[0] = d0[0]; dv[1] = d0[1]; dv[2] = d1[0]; dv[3] = d1[1];
            float uf[8], df[8]; unpack8(uv[j], uf); unpack8(dv, df);
            u32x4 o;
#pragma unroll
            for (int e = 0; e < 4; ++e) o[e] = pk2(uf[2 * e] * df[2 * e], uf[2 * e + 1] * df[2 * e + 1]);
            *(u32x4*)(YM + (size_t)(R0 + i) * DM + 512 + c8) = o;
        }
    }
    __syncthreads();
}

DI void phase_tokens(const Params& p, int l, unsigned char* lds) {
    const bool last = (l == DEPTH - 1);
    const int n_tok = (last ? NLAT : NROWS) / 64;
    const int n_chunk = (last ? NLAT : NROWS) / 128;
    unsigned* ctr = (unsigned*)(p.ws + WS_CTR) + 16 * l;
    volatile unsigned* slot = (volatile unsigned*)(lds + LDS_BYTES - 16);
    const int tid = otid();
    for (;;) {
        if (tid == 0) *slot = atomicAdd(ctr, 1u);
        __syncthreads();
        const int it = (int)*slot;
        __syncthreads();
        if (it >= n_tok + n_chunk) break;
        if (it < n_chunk) chunk_item(p, l, it, lds);
        else tok_item(p, l, it - n_chunk, lds);
    }
}

template <bool FAST>
DI void attn_unit(const Params& p, int b, int kvh, int q0, int nt, unsigned char* lds) {
    const int tid = otid(), lane = tid & 63, wid = tid >> 6, r = lane & 31, h = lane >> 5;
    const int head = 2 * kvh + (wid >> 2);
    const int qpos = q0 + (wid & 3) * 32 + r;
    const u16* Qg = (const u16*)(p.ws + WS_Q) + ((size_t)(b * 4 + head) * TKV + qpos) * 64;
    const u16* Kg = (const u16*)(p.ws + WS_K) + (size_t)(b * 2 + kvh) * TKV * 64;
    const u16* Vg = (const u16*)(p.ws + WS_VT) + (size_t)(b * 2 + kvh) * 64 * TKV;
    bf16x8 qf[4];
#pragma unroll
    for (int s = 0; s < 4; ++s) qf[s] = *(const bf16x8*)(Qg + 16 * s + 8 * h);
    f32x16 oacc[2];
#pragma unroll
    for (int e = 0; e < 16; ++e) { oacc[0][e] = 0.f; oacc[1][e] = 0.f; }
    float m_run = -1e30f, l_run = 0.f;
    const int lrow = tid >> 3, lch = tid & 7;
    const int woff = swz(lrow, lch);
    u32x4 kr, vr;
    kr = *(const u32x4*)(Kg + (size_t)lrow * 64 + lch * 8);
    vr = *(const u32x4*)(Vg + (size_t)lrow * TKV + lch * 8);
    *(u32x4*)(lds + woff) = kr;
    *(u32x4*)(lds + 8192 + woff) = vr;
    if (nt > 1) {
        kr = *(const u32x4*)(Kg + (size_t)(64 + lrow) * 64 + lch * 8);
        vr = *(const u32x4*)(Vg + (size_t)lrow * TKV + 64 + lch * 8);
    }
    __syncthreads();
    for (int t = 0; t < nt; ++t) {
        unsigned char* cur = lds + (t & 1) * 16384;
        unsigned char* nxt = lds + ((t + 1) & 1) * 16384;
        if (t + 1 < nt) {
            *(u32x4*)(nxt + woff) = kr;
            *(u32x4*)(nxt + 8192 + woff) = vr;
        }
        if (t + 2 < nt) {
            kr = *(const u32x4*)(Kg + (size_t)((t + 2) * 64 + lrow) * 64 + lch * 8);
            vr = *(const u32x4*)(Vg + (size_t)lrow * TKV + (t + 2) * 64 + lch * 8);
        }
        f32x16 sacc[2];
#pragma unroll
        for (int kb = 0; kb < 2; ++kb) {
#pragma unroll
            for (int e = 0; e < 16; ++e) sacc[kb][e] = 0.f;
#pragma unroll
            for (int s = 0; s < 4; ++s) {
                const bf16x8 kf = *(const bf16x8*)(cur + swz(kb * 32 + r, 2 * s + h));
                sacc[kb] = MFMA32(kf, qf[s], sacc[kb]);
            }
        }
        float m_new = 0.f;
        if (!FAST) {
            float mx = sacc[0][0];
#pragma unroll
            for (int e = 1; e < 16; ++e) mx = fmaxf(mx, sacc[0][e]);
#pragma unroll
            for (int e = 0; e < 16; ++e) mx = fmaxf(mx, sacc[1][e]);
            mx = fmaxf(mx, __shfl_xor(mx, 32));
            m_new = fmaxf(m_run, mx);
            const float alpha = __builtin_amdgcn_exp2f(m_run - m_new);
            m_run = m_new;
            l_run *= alpha;
#pragma unroll
            for (int e = 0; e < 16; ++e) { oacc[0][e] *= alpha; oacc[1][e] *= alpha; }
        }
        bf16x8 pf[2][2];
#pragma unroll
        for (int kb = 0; kb < 2; ++kb)
#pragma unroll
            for (int s2 = 0; s2 < 2; ++s2) {
                u32x4 pk;
#pragma unroll
                for (int e = 0; e < 4; ++e) {
                    float s0 = sacc[kb][8 * s2 + 2 * e], s1 = sacc[kb][8 * s2 + 2 * e + 1];
                    if (!FAST) { s0 -= m_new; s1 -= m_new; }
                    const float p0 = __builtin_amdgcn_exp2f(s0), p1 = __builtin_amdgcn_exp2f(s1);
                    l_run += p0; l_run += p1;
                    pk[e] = pk2(p0, p1);
                }
                pf[kb][s2] = __builtin_bit_cast(bf16x8, pk);
            }
#pragma unroll
        for (int db = 0; db < 2; ++db)
#pragma unroll
            for (int kb = 0; kb < 2; ++kb)
#pragma unroll
                for (int s2 = 0; s2 < 2; ++s2) {
                    const bf16x8 vf = *(const bf16x8*)(cur + 8192 + swz(db * 32 + r, kb * 4 + 2 * s2 + h));
                    oacc[db] = MFMA32(vf, pf[kb][s2], oacc[db]);
                }
        __syncthreads();
    }
    const float l_tot = l_run + __shfl_xor(l_run, 32);
    const float inv = 1.f / l_tot;
    const int row = (qpos >= CTX) ? b * SEQ + (qpos - CTX) : NLAT + b * CTX + qpos;
    const u16* P = (const u16*)(p.ws + WS_P) + (size_t)row * PWO + O_SDG + head * 64;
    u16* YM = (u16*)(p.ws + WS_YMIX) + (size_t)row * DM + 768 + head * 64;
#pragma unroll
    for (int db = 0; db < 2; ++db)
#pragma unroll
        for (int g = 0; g < 4; ++g) {
            const int d = db * 32 + 8 * g + 4 * h;
            const u32x2 gr = *(const u32x2*)(P + d);
            float gf[4]; unpack4(gr, gf);
            float o[4];
#pragma unroll
            for (int e = 0; e < 4; ++e) o[e] = oacc[db][4 * g + e] * inv * gf[e];
            u32x2 pk; pk[0] = pk2(o[0], o[1]); pk[1] = pk2(o[2], o[3]);
            *(u32x2*)(YM + d) = pk;
        }
}
DI void attn_unit_pipe(const Params& p, int b, int kvh, int q0, int nt, unsigned char* lds) {
    const int tid = otid(), lane = tid & 63, wid = tid >> 6, r = lane & 31, h = lane >> 5;
    const int head = 2 * kvh + (wid >> 2);
    const int qpos = q0 + (wid & 3) * 32 + r;
    const u16* Qg = (const u16*)(p.ws + WS_Q) + ((size_t)(b * 4 + head) * TKV + qpos) * 64;
    const u16* Kg = (const u16*)(p.ws + WS_K) + (size_t)(b * 2 + kvh) * TKV * 64;
    const u16* Vg = (const u16*)(p.ws + WS_VT) + (size_t)(b * 2 + kvh) * 64 * TKV;
    bf16x8 qf[4];
#pragma unroll
    for (int s = 0; s < 4; ++s) qf[s] = *(const bf16x8*)(Qg + 16 * s + 8 * h);
    f32x16 oacc[2], lacc, S0[2], S1[2];
#pragma unroll
    for (int e = 0; e < 16; ++e) { oacc[0][e] = 0.f; oacc[1][e] = 0.f; lacc[e] = 0.f; }
    bf16x8 ones;
#pragma unroll
    for (int e = 0; e < 8; ++e) ones[e] = (short)0x3F80;
    const int lrow = tid >> 3, lch = tid & 7;
    const int woff = swz(lrow, lch);
    const u16* Kl = Kg + (size_t)lrow * 64 + lch * 8;
    const u16* Vl = Vg + (size_t)lrow * TKV + lch * 8;
    unsigned char* KB = lds;
    unsigned char* VB = lds + 16384;
    u32x4 kr, vr;
    {
        const u32x4 k0 = *(const u32x4*)(Kl), v0 = *(const u32x4*)(Vl), k1 = *(const u32x4*)(Kl + 4096);
        *(u32x4*)(KB + woff) = k0; *(u32x4*)(VB + woff) = v0; *(u32x4*)(KB + 8192 + woff) = k1;
        const int t2 = 2 < nt ? 2 : nt - 1;
        kr = *(const u32x4*)(Kl + (size_t)t2 * 4096); vr = *(const u32x4*)(Vl + 64);
    }
    __syncthreads();
#pragma unroll
    for (int kb = 0; kb < 2; ++kb) {
#pragma unroll
        for (int e = 0; e < 16; ++e) S0[kb][e] = 0.f;
#pragma unroll
        for (int s = 0; s < 4; ++s) S0[kb] = MFMA32(*(const bf16x8*)(KB + swz(kb * 32 + r, 2 * s + h)), qf[s], S0[kb]);
    }
    __syncthreads();
#define ATT_STEP(SC, SN, T) do { \
        const int t_ = (T); \
        unsigned char* kw = KB + (t_ & 1) * 8192; unsigned char* vw = VB + ((t_ + 1) & 1) * 8192; \
        *(u32x4*)(kw + woff) = kr; *(u32x4*)(vw + woff) = vr; \
        { const int tk = t_ + 3 < nt ? t_ + 3 : nt - 1, tv = t_ + 2 < nt ? t_ + 2 : nt - 1; \
          kr = *(const u32x4*)(Kl + (size_t)tk * 4096); vr = *(const u32x4*)(Vl + tv * 64); } \
        const unsigned char* kc = KB + ((t_ + 1) & 1) * 8192; const unsigned char* vc = VB + (t_ & 1) * 8192; \
        bf16x8 kf[8], vf[8]; \
        _Pragma("unroll") for (int i = 0; i < 8; ++i) kf[i] = *(const bf16x8*)(kc + swz((i >> 2) * 32 + r, 2 * (i & 3) + h)); \
        _Pragma("unroll") for (int i = 0; i < 8; ++i) vf[i] = *(const bf16x8*)(vc + swz((i & 1) * 32 + r, (i >> 1) * 2 + h)); \
        __builtin_amdgcn_sched_barrier(0); \
        bf16x8 pf[2][2]; \
        _Pragma("unroll") for (int kb = 0; kb < 2; ++kb) { \
            _Pragma("unroll") for (int e = 0; e < 16; ++e) SN[kb][e] = 0.f; \
            _Pragma("unroll") for (int s = 0; s < 4; ++s) { \
                SN[kb] = MFMA32(kf[kb * 4 + s], qf[s], SN[kb]); \
                const float e0 = __builtin_amdgcn_exp2f(SC[kb][4 * s]), e1 = __builtin_amdgcn_exp2f(SC[kb][4 * s + 1]); \
                const float e2 = __builtin_amdgcn_exp2f(SC[kb][4 * s + 2]), e3 = __builtin_amdgcn_exp2f(SC[kb][4 * s + 3]); \
                u32x4 t4 = __builtin_bit_cast(u32x4, pf[kb][s >> 1]); \
                t4[(s & 1) * 2] = pk2(e0, e1); t4[(s & 1) * 2 + 1] = pk2(e2, e3); \
                pf[kb][s >> 1] = __builtin_bit_cast(bf16x8, t4); \
            } \
        } \
        _Pragma("unroll") for (int kb = 0; kb < 2; ++kb) \
            _Pragma("unroll") for (int s2 = 0; s2 < 2; ++s2) { \
                _Pragma("unroll") for (int db = 0; db < 2; ++db) \
                    oacc[db] = MFMA32(vf[(kb * 2 + s2) * 2 + db], pf[kb][s2], oacc[db]); \
                lacc = MFMA32(ones, pf[kb][s2], lacc); \
            } \
        __syncthreads(); \
    } while (0)
    int t = 0;
    for (; t + 2 <= nt - 1; t += 2) { ATT_STEP(S0, S1, t); ATT_STEP(S1, S0, t + 1); }
    if (t < nt - 1) {
        ATT_STEP(S0, S1, t);
#pragma unroll
        for (int kb = 0; kb < 2; ++kb) S0[kb] = S1[kb];
    }
#undef ATT_STEP
    {
        const unsigned char* vc = VB + ((nt - 1) & 1) * 8192;
#pragma unroll
        for (int kb = 0; kb < 2; ++kb)
#pragma unroll
            for (int s2 = 0; s2 < 2; ++s2) {
                u32x4 pk;
#pragma unroll
                for (int e = 0; e < 4; ++e) pk[e] = pk2(__builtin_amdgcn_exp2f(S0[kb][8 * s2 + 2 * e]), __builtin_amdgcn_exp2f(S0[kb][8 * s2 + 2 * e + 1]));
                const bf16x8 pfr = __builtin_bit_cast(bf16x8, pk);
#pragma unroll
                for (int db = 0; db < 2; ++db)
                    oacc[db] = MFMA32(*(const bf16x8*)(vc + swz(db * 32 + r, kb * 4 + 2 * s2 + h)), pfr, oacc[db]);
                lacc = MFMA32(ones, pfr, lacc);
            }
    }
    __syncthreads();
    const float inv = 1.f / lacc[0];
    const int row = (qpos >= CTX) ? b * SEQ + (qpos - CTX) : NLAT + b * CTX + qpos;
    const u16* P = (const u16*)(p.ws + WS_P) + (size_t)row * PWO + O_SDG + head * 64;
    u16* YM = (u16*)(p.ws + WS_YMIX) + (size_t)row * DM + 768 + head * 64;
#pragma unroll
    for (int db = 0; db < 2; ++db)
#pragma unroll
        for (int g = 0; g < 4; ++g) {
            const int d = db * 32 + 8 * g + 4 * h;
            const u32x2 gr = *(const u32x2*)(P + d);
            float gf[4]; unpack4(gr, gf);
            float o[4];
#pragma unroll
            for (int e = 0; e < 4; ++e) o[e] = oacc[db][4 * g + e] * inv * gf[e];
            u32x2 pk; pk[0] = pk2(o[0], o[1]); pk[1] = pk2(o[2], o[3]);
            *(u32x2*)(YM + d) = pk;
        }
}
template <bool FAST>
DI void attn_units(const Params& p, int nunits, unsigned char* lds) {
    for (int u = vbid(); u < nunits; u += gridDim.x) {
        int b, kvh, q0, nt;
        if (u < 512) { b = u >> 7; kvh = (u >> 6) & 1; q0 = CTX + (u & 63) * 128; nt = TKV / 64; }
        else { const int v = u - 512; b = v >> 2; kvh = (v >> 1) & 1; q0 = (v & 1) * 128; nt = CTX / 64; }
        if (FAST) attn_unit_pipe(p, b, kvh, q0, nt, lds); else attn_unit<false>(p, b, kvh, q0, nt, lds);
    }
}
DI void phase_attn(const Params& p, int l, unsigned char* lds) {
    const bool last = (l == DEPTH - 1);
    const int nunits = 512 + (last ? 0 : 16);
    const int lane = otid() & 63;
    float qm = fabsf(p.q_gain[l * 64 + lane]), km = fabsf(p.k_gain[l * 64 + lane]);
#pragma unroll
    for (int o = 1; o < 64; o <<= 1) { qm = fmaxf(qm, __shfl_xor(qm, o)); km = fmaxf(km, __shfl_xor(km, o)); }
    const float bound = QSCALE * 64.f * qm * km;
    if (bound < 30.f) attn_units<true>(p, nunits, lds);
    else attn_units<false>(p, nunits, lds);
}

struct OneTile {
    int pm, pn;
    __device__ __forceinline__ bool next(int i, pg8::Unit& u) const { if (i) return false; u.pm = pm; u.pn = pn; return true; }
    __device__ __forceinline__ void a_ready(const pg8::Unit&) const {}
    __device__ __forceinline__ void done(const pg8::Unit&) const {}
};
DI void phase_residual(const Params& p, int l, unsigned char* lds) {
    const int tid = otid(), wid = tid >> 6, bid = obid(), G = (int)gridDim.x;
    const bool last = (l == DEPTH - 1);
    const int nctx = (!last && G > 32) ? 16 : 0;
    if (bid >= G - nctx) {
        const int u = bid - (G - nctx), panel = u >> 2, pn = u & 3;
        pg8::Gemm g{(const u16*)(p.ws + WS_YMIX), (const u16*)(p.ws + WS_WTOUT) + (size_t)l * DM * DM, NROWS, DM, DM};
        OneTile S{NLAT / 256 + panel, pn};
        pg8::EpiPlain E{(u16*)(p.ws + WS_H), DM};
        pg8::gemm_phase<pg8::EpiPlain, OneTile, false, true>((PG8_LAS unsigned char*)lds, g, S, E);
        grid_barrier((unsigned*)(p.ws + WS_PANEL) + 16 * (l * 4 + panel), 4u);
        const int rb = NLAT + panel * 256 + pn * 64 + wid * 8;
        residual_rows(p, l, rb, rb + 8);
    } else {
        const int nw = (G - nctx) * 8, gw = bid * 8 + wid;
        const int nrows = (last || nctx) ? NLAT : NROWS;
        const int rpw = (nrows + nw - 1) / nw;
        const int r0 = gw * rpw, r1 = (r0 + rpw < nrows) ? r0 + rpw : nrows;
        residual_rows(p, l, r0, r1);
    }
}

constexpr int PPL = 4;
constexpr int N_PHASES = 2 + PPL * DEPTH;
DI void run_phase(const Params& p, int ph, unsigned char* lds) {
#ifndef ONLY
#define ONLY -1
#endif
    if (ph == 0) {
        phase_prologue(p, lds);
        if (threadIdx.x == 0) {
            unsigned* mc = (unsigned*)(p.ws + WS_MODCNT);
            while (__hip_atomic_load(mc, __ATOMIC_RELAXED, __HIP_MEMORY_SCOPE_AGENT) < (unsigned)(DEPTH * 48)) __builtin_amdgcn_s_sleep(2);
            __builtin_amdgcn_fence(__ATOMIC_ACQUIRE, "agent");
            asm volatile("s_waitcnt vmcnt(0)" ::: "memory");
        }
        __syncthreads();
        phase_prenorm0(p);
        return;
    }
    if (ph == 1) return;
    const int l = (ph - 2) / PPL, s0 = (ph - 2) % PPL, s = s0 >= 2 ? s0 + 1 : s0;
    const bool last = (l == DEPTH - 1);

    pg8::StaticOrder S;
    if (s == 0) {
        pg8::Gemm g{(const u16*)(p.ws + WS_H), (const u16*)(p.ws + WS_WTIN) + (size_t)l * PW * DM, NROWS, PW, DM};
        S.init(NROWS, PW, (int)gridDim.x, obid());
        pg8::EpiInProj E{(u16*)(p.ws + WS_P), (u16*)(p.ws + WS_Q), (u16*)(p.ws + WS_K), (u16*)(p.ws + WS_VT), p.q_gain + l * 64, p.k_gain + l * 64, (const float*)(p.ws + WS_ROPE), last};
        pg8::gemm_phase<pg8::EpiInProj, pg8::StaticOrder, true, true>((PG8_LAS unsigned char*)lds, g, S, E);
    }
    else if (s == 1) { phase_attn(p, l, lds); phase_tokens(p, l, lds); }
    else if (s == 3) {
        const int M = (last || gridDim.x > 32) ? NLAT : NROWS;
        pg8::Gemm g{(const u16*)(p.ws + WS_YMIX), (const u16*)(p.ws + WS_WTOUT) + (size_t)l * DM * DM, M, DM, DM};
        S.init(M, DM, (int)gridDim.x, obid());
        pg8::EpiPlain E{(u16*)(p.ws + WS_H), DM};
        pg8::gemm_phase<pg8::EpiPlain, pg8::StaticOrder, true, true>((PG8_LAS unsigned char*)lds, g, S, E);
    }
    else phase_residual(p, l, lds);
}

#define XB_TMO      128
#define XB_XCNT(j)  (256  + 64 * (j))
#define XB_XSUB(j)  (1280 + 64 * (j))
#define XB_XGEN(j)  (2304 + 64 * (j))
#define XB_TOP      3328
#define XB_TOPGEN   3392
#define XCD_BAR_WORDS 3456
#define XB_SPIN_CAP (1u << 18)
#define LAS __attribute__((address_space(3)))

__device__ __forceinline__ unsigned xb_ld(unsigned* p)              { return __hip_atomic_load(p, __ATOMIC_RELAXED, __HIP_MEMORY_SCOPE_AGENT); }
__device__ __forceinline__ unsigned xb_add(unsigned* p, unsigned v) { return __hip_atomic_fetch_add(p, v, __ATOMIC_RELAXED, __HIP_MEMORY_SCOPE_AGENT); }
__device__ __forceinline__ unsigned xb_xcc_id() { return (unsigned)__builtin_amdgcn_s_getreg((3 << 11) | 20) & 0xFu; }
#define XB_SPIN(cond, bar) do { unsigned _sp = 0; while (cond) { __builtin_amdgcn_s_sleep(1); \
    if ((++_sp & 255u) == 0u) { if (xb_ld(&(bar)[XB_TMO])) break; if (_sp > XB_SPIN_CAP) { atomicAdd(&(bar)[XB_TMO], 1u); break; } } } } while (0)

struct XcdBarrier {
    unsigned* bar; unsigned x;
    volatile LAS unsigned* st;
};

__device__ __forceinline__ XcdBarrier xcd_barrier_post(unsigned* bar, volatile LAS unsigned* st) {
    XcdBarrier b; b.bar = bar; b.x = xb_xcc_id(); b.st = st;
    if (threadIdx.x == 0) (void)xb_add(&bar[XB_XCNT(b.x)], 1u);
    return b;
}
__device__ __forceinline__ void xcd_barrier_complete(unsigned* bar, unsigned x, unsigned& nloc, unsigned& nx) {
    const unsigned G = gridDim.x * gridDim.y * gridDim.z;
    unsigned sum, cnt, mine, sp = 0u;
    for (;;) {
        sum = 0u; cnt = 0u; mine = 0u;
#pragma unroll
        for (unsigned j = 0; j < 16; ++j) { const unsigned c = xb_ld(&bar[XB_XCNT(j)]); sum += c; cnt += (c > 0u) ? 1u : 0u; mine = (j == x) ? c : mine; }
        if (sum == G) break;
        __builtin_amdgcn_s_sleep(1);
        if ((++sp & 255u) == 0u) { if (xb_ld(&bar[XB_TMO])) break; if (sp > XB_SPIN_CAP) { atomicAdd(&bar[XB_TMO], 1u); break; } }
    }
    nloc = mine > 0u ? mine : 1u; nx = cnt > 0u ? cnt : 1u;
}

__device__ __forceinline__ void xcd_barrier(const XcdBarrier& b) {
    asm volatile("s_waitcnt vmcnt(0)" ::: "memory");
    __syncthreads();
    if (threadIdx.x == 0) {
        unsigned* bar = b.bar;
        __builtin_amdgcn_s_waitcnt(0);
        unsigned nloc = b.st[0], nx = b.st[1];
        if (nloc == 0u) { xcd_barrier_complete(bar, b.x, nloc, nx); b.st[0] = nloc; b.st[1] = nx; }
        const unsigned old = xb_add(&bar[XB_XSUB(b.x)], 1u);
        const unsigned gen = old / nloc;
        if (old + 1u == (gen + 1u) * nloc) {
            __builtin_amdgcn_fence(__ATOMIC_RELEASE, "agent");
            asm volatile("s_waitcnt vmcnt(0)" ::: "memory");
            const unsigned og = xb_add(&bar[XB_TOP], 1u);
            const unsigned tg = og / nx;
            if (og + 1u == (tg + 1u) * nx) xb_add(&bar[XB_TOPGEN], 1u);
            else XB_SPIN(xb_ld(&bar[XB_TOPGEN]) == tg, bar);
            __builtin_amdgcn_fence(__ATOMIC_ACQUIRE, "agent");
            xb_add(&bar[XB_XGEN(b.x)], 1u);
            asm volatile("s_waitcnt vmcnt(0)" ::: "memory");
        } else {
            XB_SPIN(xb_ld(&bar[XB_XGEN(b.x)]) == gen, bar);
            __builtin_amdgcn_fence(__ATOMIC_ACQUIRE, "agent");
            asm volatile("s_waitcnt vmcnt(0)" ::: "memory");
        }
    }
    __syncthreads();
}


template <bool COOP>
__global__ void __launch_bounds__(NTHREADS) fwd_kernel(Params p) {
    extern __shared__ __attribute__((aligned(16))) unsigned char lds[];
    if (COOP) {
        cg::grid_group grid = cg::this_grid();
        volatile LAS unsigned* st = (volatile LAS unsigned*)(lds + LDS_BYTES - 32);
        if (threadIdx.x == 0) { st[0] = 0u; st[1] = 0u; }
        __syncthreads();
        XcdBarrier xb = xcd_barrier_post((unsigned*)(p.ws + WS_XBAR), st);
        for (int ph = p.ph_lo; ph < p.ph_hi; ++ph) {
            run_phase(p, ph, lds);
#ifdef REP_S
            if ((REP_S < 0 && ph == 0) || (ph >= 2 && (ph - 2) % PPL == REP_S)) { xcd_barrier(xb); run_phase(p, ph, lds); }
#endif
            if (ph + 1 < p.ph_hi) {
                if (p.ph_lo < 0) grid.sync();
                if (ph != 0) xcd_barrier(xb);
            }
        }
    } else {
        for (int ph = p.ph_lo; ph < p.ph_hi; ++ph) run_phase(p, ph, lds);
    }
}

extern "C" void kernel_launch(void* const* d_in, const int* in_sizes, int n_in, void* d_out, int out_size, void* d_ws,
                              size_t ws_size, hipStream_t stream) {
    static int grid = 0;
    if (grid == 0) {
        if (n_in != 21 || ws_size < WS_END) { fprintf(stderr, "kernel_launch: unexpected inputs (n_in %d, ws %zu, need %zu)\n", n_in, ws_size, (size_t)WS_END); grid = -1; return; }
        int dev = 0, cus = 0, per_cu = 0;
        hipGetDevice(&dev);
        hipDeviceGetAttribute(&cus, hipDeviceAttributeMultiprocessorCount, dev);
        hipFuncSetAttribute((const void*)fwd_kernel<true>, hipFuncAttributeMaxDynamicSharedMemorySize, LDS_BYTES);
        hipFuncSetAttribute((const void*)fwd_kernel<false>, hipFuncAttributeMaxDynamicSharedMemorySize, LDS_BYTES);
        hipOccupancyMaxActiveBlocksPerMultiprocessor(&per_cu, (const void*)fwd_kernel<true>, NTHREADS, LDS_BYTES);
        if (per_cu < 1) per_cu = 1;
        grid = cus * per_cu;
        (void)hipGetLastError();
    }
    if (grid < 0) return;
    Params p{};
    const float** pp = (const float**)&p;
    for (int i = 0; i < 21; ++i) pp[i] = (const float*)d_in[i];
    p.out = (float*)d_out;
    p.ws = (unsigned char*)d_ws;
#if MK_COOP
    (void)hipMemsetAsync((unsigned char*)d_ws + WS_CTR, 0, WS_END - WS_CTR, stream);
    p.ph_lo = 0; p.ph_hi = N_PHASES;
    void* args[] = {&p};
    hipError_t e = hipLaunchCooperativeKernel((const void*)fwd_kernel<true>, dim3(grid), dim3(NTHREADS), args, LDS_BYTES, stream);
    if (e != hipSuccess) fprintf(stderr, "cooperative launch failed: %s (grid %d)\n", hipGetErrorString(e), grid);
#else
    for (int ph = 0; ph < N_PHASES; ++ph) {
        p.ph_lo = ph; p.ph_hi = ph + 1;
        hipLaunchKernelGGL(fwd_kernel<false>, dim3(grid), dim3(NTHREADS), LDS_BYTES, stream, p);
    }
#endif
}
```

```cpp
#include <hip/hip_runtime.h>
#include <hip/hip_cooperative_groups.h>
#include <cstdio>
#include <cstdint>
namespace cg = cooperative_groups;

#ifndef MK_COOP
#define MK_COOP 1
#endif

typedef unsigned short u16;
using bf16x8 = __attribute__((ext_vector_type(8))) short;
using f32x16 = __attribute__((ext_vector_type(16))) float;
using f32x4  = __attribute__((ext_vector_type(4))) float;
using u32x4  = __attribute__((ext_vector_type(4))) unsigned;
using u32x2  = __attribute__((ext_vector_type(2))) unsigned;
#define DI __device__ __forceinline__
#define MFMA32(a, b, c) __builtin_amdgcn_mfma_f32_32x32x16_bf16((a), (b), (c), 0, 0, 0)

constexpr int DM = 1024, BATCH = 4, SEQ = 8192, DEPTH = 4, CTX = 256, PW = 3328;
constexpr int NLAT = BATCH * SEQ;
constexpr int NROWS = NLAT + BATCH * CTX;
constexpr int TKV = CTX + SEQ;
constexpr int NTHREADS = 512;
constexpr int LDS_BYTES = 140 * 1024;
constexpr float QSCALE = 0.125f * 1.4426950408889634f;

constexpr int C_AB = 0, C_AC = 256, C_AH = 512, C_AG = 768, C_BGLU = 1024, C_BG = 1536, C_CU = 1792, C_CV = 2048,
              C_CG = 2304, C_Q = 2560, C_K = 2816, C_V = 2944, C_DG = 3072;

constexpr int PWO = 1792, O_CX = 0, O_ABG = 256, O_Z = 512, O_SBG = 768, O_UG = 1024, O_CV = 1280, O_SDG = 1536;
constexpr size_t WS_WTIN = 0;
constexpr size_t WS_WTOUT = WS_WTIN + (size_t)DEPTH * PW * DM * 2;
constexpr size_t WS_WSBF = WS_WTOUT + (size_t)DEPTH * DM * DM * 2;
constexpr size_t WS_MOD = WS_WSBF + (size_t)DEPTH * 4 * 128 * 128 * 2;
constexpr size_t WS_ROPE = WS_MOD + (size_t)DEPTH * 5 * 3072 * 4;
constexpr size_t WS_H = WS_ROPE + (size_t)128 * 16 * 2 * 4;
constexpr size_t WS_P = WS_H + (size_t)NROWS * DM * 2;
constexpr size_t WS_Q = WS_P + (size_t)NROWS * 1792 * 2;
constexpr size_t WS_K = WS_Q + (size_t)BATCH * 4 * TKV * 64 * 2;
constexpr size_t WS_VT = WS_K + (size_t)BATCH * 2 * TKV * 64 * 2;
constexpr size_t WS_YMIX = WS_VT + (size_t)BATCH * 2 * TKV * 64 * 2;
constexpr size_t WS_XC = WS_YMIX + (size_t)NROWS * DM * 2;
constexpr size_t WS_CTR = WS_XC + (size_t)NROWS * DM * 2;
constexpr size_t WS_BAR = WS_CTR + 64 * DEPTH;
constexpr size_t WS_PANEL = WS_BAR + 64;
constexpr size_t WS_XBAR = WS_PANEL + 64 * 4 * DEPTH;
constexpr size_t WS_END = WS_XBAR + 3456 * 4;

struct Params {
    const float *x, *c, *ctx, *c_ctx, *w_mod, *b_mod, *g_pre, *g_post, *w_in, *w_out, *conv_a, *conv_b, *conv_b_bias,
        *conf_ln_g, *conf_ln_b, *sgu_ln_g, *sgu_ln_b, *w_s, *b_s, *q_gain, *k_gain;
    float* out;
    unsigned char* ws;
    int ph_lo, ph_hi;
};

DI unsigned f2bf(float x) { unsigned u = __float_as_uint(x); u += 0x7fffu + ((u >> 16) & 1u); return u >> 16; }
typedef __bf16 bf16x2_t __attribute__((ext_vector_type(2)));
typedef float f32x2_t __attribute__((ext_vector_type(2)));
DI unsigned pk2(float lo, float hi) { f32x2_t v = {lo, hi}; bf16x2_t r = __builtin_convertvector(v, bf16x2_t); return __builtin_bit_cast(unsigned, r); }
DI float bflo(unsigned u) { return __uint_as_float(u << 16); }
DI float bfhi(unsigned u) { return __uint_as_float(u & 0xffff0000u); }
DI float bf1(u16 u) { return __uint_as_float(((unsigned)u) << 16); }
DI float sigmoidf_(float x) { return __builtin_amdgcn_rcpf(1.f + __expf(-x)); }
DI float siluf_(float x) { return x * __builtin_amdgcn_rcpf(1.f + __expf(-x)); }
DI int crow(int reg, int h) { return (reg & 3) + 8 * (reg >> 2) + 4 * h; }
DI void unpack8(u32x4 v, float* f) {
    f[0] = bflo(v[0]); f[1] = bfhi(v[0]); f[2] = bflo(v[1]); f[3] = bfhi(v[1]);
    f[4] = bflo(v[2]); f[5] = bfhi(v[2]); f[6] = bflo(v[3]); f[7] = bfhi(v[3]);
}
DI void unpack4(u32x2 v, float* f) { f[0] = bflo(v[0]); f[1] = bfhi(v[0]); f[2] = bflo(v[1]); f[3] = bfhi(v[1]); }
DI float wave_sum(float v) {
#pragma unroll
    for (int o = 1; o < 64; o <<= 1) v += __shfl_xor(v, o);
    return v;
}
DI int otid() { int t = threadIdx.x; asm volatile("" : "+v"(t)); return t; }
DI int obid() { int b = blockIdx.x; asm volatile("" : "+s"(b)); return b; }
DI int vbid() { const int b = obid(); const int per = gridDim.x >> 3; return (gridDim.x & 7) ? b : (b & 7) * per + (b >> 3); }
DI void grid_barrier(unsigned* cnt, unsigned target) {
    asm volatile("s_waitcnt vmcnt(0) lgkmcnt(0)" ::: "memory");
    __syncthreads();
    if (threadIdx.x == 0) {
        __builtin_amdgcn_fence(__ATOMIC_RELEASE, "agent");
        __hip_atomic_fetch_add(cnt, 1u, __ATOMIC_RELAXED, __HIP_MEMORY_SCOPE_AGENT);
        while (__hip_atomic_load(cnt, __ATOMIC_RELAXED, __HIP_MEMORY_SCOPE_AGENT) < target) __builtin_amdgcn_s_sleep(2);
        __builtin_amdgcn_fence(__ATOMIC_ACQUIRE, "agent");
        asm volatile("s_waitcnt vmcnt(0)" ::: "memory");
    }
    __syncthreads();
}

DI int swz(int row, int chunk) { return row * 128 + ((chunk ^ ((row >> 1) & 7)) << 4); }

DI int src_col(int n) {
    const int T = n >> 8, c = n & 255, bj = c >> 7, j = c & 127;
    switch (T) {
        case 0: case 1: return (bj ? C_AH : C_AC) + (T & 1) * 128 + j;
        case 2: case 3: return (bj ? C_AG : C_AB) + (T & 1) * 128 + j;
        case 4: case 5: return C_BGLU + (bj ? 256 : 0) + (T & 1) * 128 + j;
        case 6: return C_BG + c;
        case 7: case 8: return (bj ? C_CG : C_CU) + ((T - 7) & 1) * 128 + j;
        case 9: return C_CV + c;
        case 10: case 11: { const int wc = (c >> 5) & 3, fq = (c >> 3) & 3, nn = (c >> 2) & 1, e = c & 3; return (T << 8) + 64 * wc + 32 * bj + 16 * nn + 4 * fq + e; }
        default: return n;
    }
}
template <bool PERMUTE>
DI void transpose_item(const float* W, int N, u16* WT, int kb, int nb, float* scr) {
    const int tid = otid();
    const int k0 = kb * 64, n0 = nb * 128;
    const int n4 = (tid & 31) * 4, kr = tid >> 5;
    const int nsrc = PERMUTE ? src_col(n0 + n4) : n0 + n4;
    f32x4 v[4];
#pragma unroll
    for (int i = 0; i < 4; ++i) v[i] = *(const f32x4*)(W + (size_t)(k0 + kr + 16 * i) * N + nsrc);
#pragma unroll
    for (int i = 0; i < 4; ++i) {
        float* d = scr + (kr + 16 * i) * 129 + n4;
        d[0] = v[i][0]; d[1] = v[i][1]; d[2] = v[i][2]; d[3] = v[i][3];
    }
    __syncthreads();
    const int c = tid & 7;
#pragma unroll
    for (int j = 0; j < 2; ++j) {
        const int n = (tid >> 3) + 64 * j;
        const float* s = scr + (8 * c) * 129 + n;
        u32x4 o;
        o[0] = pk2(s[0], s[129]); o[1] = pk2(s[258], s[387]); o[2] = pk2(s[516], s[645]); o[3] = pk2(s[774], s[903]);
        *(u32x4*)(WT + (size_t)(n0 + n) * 1024 + k0 + 8 * c) = o;
    }
    __syncthreads();
}

DI void phase_prologue(const Params& p, unsigned char* lds) {
    float* scr = (float*)lds;
    const int tid = otid(), lane = tid & 63, wid = tid >> 6;
    u16* wtin = (u16*)(p.ws + WS_WTIN);
    u16* wtout = (u16*)(p.ws + WS_WTOUT);
    constexpr int I_IN = 16 * 26, I_OUT = 16 * 8;
    constexpr int N_TR = DEPTH * (I_IN + I_OUT);
    constexpr int N_MOD = DEPTH * 48;
    for (int it = obid(); it < N_TR + N_MOD; it += gridDim.x) {
        if (it >= N_MOD) {
            const int it2 = it - N_MOD;
            const int l = it2 / (I_IN + I_OUT);
            int r = it2 % (I_IN + I_OUT);
            if (r < I_IN) transpose_item<true>(p.w_in + (size_t)l * DM * PW, PW, wtin + (size_t)l * PW * DM, r / 26, r % 26, scr);
            else { r -= I_IN; transpose_item<false>(p.w_out + (size_t)l * DM * DM, DM, wtout + (size_t)l * DM * DM, r / 8, r % 8, scr); }
        } else {
            const int m = it, l = m / 48, cb = m % 48;
            float* sv = scr;
            float* red = scr + 5 * 1024;
            for (int i = tid; i < 5 * 1024; i += NTHREADS) {
                const int v = i >> 10, k = i & 1023;
                const float cv = (v < 4) ? p.c[v * 1024 + k] : p.c_ctx[k];
                sv[i] = siluf_(cv);
            }
            __syncthreads();
            const float* W = p.w_mod + (size_t)l * DM * 3072 + cb * 64 + lane;
            float a0 = 0, a1 = 0, a2 = 0, a3 = 0, a4 = 0;
#pragma unroll 1
            for (int k0 = wid * 128; k0 < wid * 128 + 128; k0 += 16) {
                float wv[16];
#pragma unroll
                for (int j = 0; j < 16; ++j) wv[j] = W[(size_t)(k0 + j) * 3072];
#pragma unroll
                for (int j = 0; j < 16; ++j) {
                    const int k = k0 + j; const float w = wv[j];
                    a0 += sv[k] * w; a1 += sv[1024 + k] * w; a2 += sv[2048 + k] * w; a3 += sv[3072 + k] * w; a4 += sv[4096 + k] * w;
                }
            }
            red[(wid * 5 + 0) * 64 + lane] = a0; red[(wid * 5 + 1) * 64 + lane] = a1; red[(wid * 5 + 2) * 64 + lane] = a2;
            red[(wid * 5 + 3) * 64 + lane] = a3; red[(wid * 5 + 4) * 64 + lane] = a4;
            __syncthreads();
            if (tid < 320) {
                const int v = tid >> 6, n = tid & 63;
                float s = 0;
#pragma unroll
                for (int w = 0; w < 8; ++w) s += red[(w * 5 + v) * 64 + n];
                s += p.b_mod[l * 3072 + cb * 64 + n];
                ((float*)(p.ws + WS_MOD))[(l * 5 + v) * 3072 + cb * 64 + n] = s;
            }
            __syncthreads();
        }
    }
    const int gt = obid() * NTHREADS + tid, gs = gridDim.x * NTHREADS;
    u16* wsbf = (u16*)(p.ws + WS_WSBF);
    for (int i = gt; i < DEPTH * 4 * 128 * 128; i += gs) wsbf[i] = (u16)f2bf(p.w_s[i]);
    float* rope = (float*)(p.ws + WS_ROPE);
    for (int i = gt; i < 128 * 16; i += gs) {
        const int pos = i >> 4, f = i & 15;
        const float invf = exp2f(-(float)f * (13.287712379549449f / 16.0f));
        const float ang = (float)pos * invf;
        const float tr = ang * 0.15915494309189535f;
        const float fr = tr - floorf(tr);
        rope[2 * i] = __builtin_amdgcn_cosf(fr);
        rope[2 * i + 1] = __builtin_amdgcn_sinf(fr);
    }
}

DI const float* mod_ptr(const Params& p, int l, int row) {
    const int v = row < NLAT ? row / SEQ : 4;
    return (const float*)(p.ws + WS_MOD) + (size_t)(l * 5 + v) * 3072;
}
DI void write_h(const Params& p, int l, int row, const f32x4* xv, int lane) {
    float ss = 0;
#pragma unroll
    for (int j = 0; j < 4; ++j) ss += xv[j][0] * xv[j][0] + xv[j][1] * xv[j][1] + xv[j][2] * xv[j][2] + xv[j][3] * xv[j][3];
    ss = wave_sum(ss);
    const float rstd = rsqrtf(ss * (1.f / DM) + 1e-6f);
    const float* md = mod_ptr(p, l, row);
    const float* gp = p.g_pre + l * DM;
    u16* H = (u16*)(p.ws + WS_H) + (size_t)row * DM;
#pragma unroll
    for (int j = 0; j < 4; ++j) {
        const int idx = j * 256 + lane * 4;
        const f32x4 g = *(const f32x4*)(gp + idx), sh = *(const f32x4*)(md + idx), sc = *(const f32x4*)(md + 1024 + idx);
        float o[4];
#pragma unroll
        for (int e = 0; e < 4; ++e) o[e] = xv[j][e] * rstd * g[e] * (1.f + sc[e]) + sh[e];
        u32x2 pk; pk[0] = pk2(o[0], o[1]); pk[1] = pk2(o[2], o[3]);
        *(u32x2*)(H + idx) = pk;
    }
}
DI void phase_prenorm0(const Params& p) {
    const int tid = otid(), lane = tid & 63, gw = obid() * 8 + (tid >> 6), nw = gridDim.x * 8;
    for (int row = gw; row < NROWS; row += nw) {
        const float* xr = row < NLAT ? p.x + (size_t)row * DM : p.ctx + (size_t)(row - NLAT) * DM;
        f32x4 xv[4];
#pragma unroll
        for (int j = 0; j < 4; ++j) xv[j] = *(const f32x4*)(xr + j * 256 + lane * 4);
        write_h(p, 0, row, xv, lane);
    }
}
DI void residual_rows(const Params& p, int l, int r0, int r1) {
    const int tid = otid(), lane = tid & 63;
    const bool last = (l == DEPTH - 1);
    if (r0 >= r1) return;
    const u16* YO = (const u16*)(p.ws + WS_H);
    u16* H = (u16*)(p.ws + WS_H);
    u16* XS = (u16*)(p.ws + WS_XC);
    const bool first = (l == 0);
    const float* modb = (const float*)(p.ws + WS_MOD);
    float gpost[16], gpre[16], gt[16], sh[16], sc[16];
#define RES_V16(DST, SRC) do { _Pragma("unroll") for (int j = 0; j < 2; ++j) { const f32x4 a_ = *(const f32x4*)((SRC) + j * 512 + lane * 8), b_ = *(const f32x4*)((SRC) + j * 512 + lane * 8 + 4); \
        _Pragma("unroll") for (int e = 0; e < 4; ++e) { DST[j * 8 + e] = a_[e]; DST[j * 8 + 4 + e] = b_[e]; } } } while (0)
    RES_V16(gpost, p.g_post + l * DM);
    if (!last) RES_V16(gpre, p.g_pre + (l + 1) * DM);
    else { _Pragma("unroll") for (int e = 0; e < 16; ++e) gpre[e] = 0.f; }
#pragma unroll
    for (int e = 0; e < 16; ++e) { gt[e] = 0.f; sh[e] = 0.f; sc[e] = 0.f; }
    int curv = -1;
    f32x4 xnA[4], xnB[4]; u32x4 xnbA[2], xnbB[2], ynA[2], ynB[2];
#define RES_LOAD(XN, XNB, YN, R) do { const int r_ = (R); \
        if (first) { const float* xr = r_ < NLAT ? p.x + (size_t)r_ * DM : p.ctx + (size_t)(r_ - NLAT) * DM; \
            _Pragma("unroll") for (int j = 0; j < 2; ++j) { XN[2 * j] = *(const f32x4*)(xr + j * 512 + lane * 8); XN[2 * j + 1] = *(const f32x4*)(xr + j * 512 + lane * 8 + 4); } } \
        else { _Pragma("unroll") for (int j = 0; j < 2; ++j) XNB[j] = *(const u32x4*)(XS + (size_t)r_ * DM + j * 512 + lane * 8); } \
        _Pragma("unroll") for (int j = 0; j < 2; ++j) YN[j] = *(const u32x4*)(YO + (size_t)r_ * DM + j * 512 + lane * 8); } while (0)
    auto proc = [&](f32x4 (&xn)[4], u32x4 (&xnb)[2], u32x4 (&yn)[2], const int row, const int rnext) __attribute__((always_inline)) {
        float xv[16], yv[16];
#pragma unroll
        for (int j = 0; j < 2; ++j) {
            if (first) { _Pragma("unroll") for (int e = 0; e < 4; ++e) { xv[j * 8 + e] = xn[2 * j][e]; xv[j * 8 + 4 + e] = xn[2 * j + 1][e]; } }
            else unpack8(xnb[j], xv + j * 8);
            unpack8(yn[j], yv + j * 8);
        }
        if (rnext < r1) RES_LOAD(xn, xnb, yn, rnext);
        const int v = row < NLAT ? row / SEQ : 4;
        if (v != curv) {
            curv = v;
            RES_V16(gt, modb + (size_t)(l * 5 + v) * 3072 + 2048);
            if (!last) { RES_V16(sh, modb + (size_t)((l + 1) * 5 + v) * 3072); RES_V16(sc, modb + (size_t)((l + 1) * 5 + v) * 3072 + 1024); }
        }
        float ss = 0.f;
#pragma unroll
        for (int e = 0; e < 16; ++e) ss += yv[e] * yv[e];
        ss = wave_sum(ss);
        const float rstd = rsqrtf(ss * (1.f / DM) + 1e-6f);
        float s2 = 0.f;
#pragma unroll
        for (int e = 0; e < 16; ++e) { xv[e] = xv[e] + gt[e] * (yv[e] * rstd * gpost[e]); s2 += xv[e] * xv[e]; }
        if (last) {
            float* xw = p.out + (size_t)row * DM;
#pragma unroll
            for (int j = 0; j < 2; ++j) {
                *(f32x4*)(xw + j * 512 + lane * 8) = (f32x4){xv[j * 8], xv[j * 8 + 1], xv[j * 8 + 2], xv[j * 8 + 3]};
                *(f32x4*)(xw + j * 512 + lane * 8 + 4) = (f32x4){xv[j * 8 + 4], xv[j * 8 + 5], xv[j * 8 + 6], xv[j * 8 + 7]};
            }
        } else {
#pragma unroll
            for (int j = 0; j < 2; ++j) {
                u32x4 pk; pk[0] = pk2(xv[j * 8], xv[j * 8 + 1]); pk[1] = pk2(xv[j * 8 + 2], xv[j * 8 + 3]); pk[2] = pk2(xv[j * 8 + 4], xv[j * 8 + 5]); pk[3] = pk2(xv[j * 8 + 6], xv[j * 8 + 7]);
                *(u32x4*)(XS + (size_t)row * DM + j * 512 + lane * 8) = pk;
            }
            s2 = wave_sum(s2);
            const float rs2 = rsqrtf(s2 * (1.f / DM) + 1e-6f);
#pragma unroll
            for (int j = 0; j < 2; ++j) {
                float o[8];
#pragma unroll
                for (int e = 0; e < 8; ++e) o[e] = xv[j * 8 + e] * rs2 * gpre[j * 8 + e] * (1.f + sc[j * 8 + e]) + sh[j * 8 + e];
                u32x4 pk; pk[0] = pk2(o[0], o[1]); pk[1] = pk2(o[2], o[3]); pk[2] = pk2(o[4], o[5]); pk[3] = pk2(o[6], o[7]);
                *(u32x4*)(H + (size_t)row * DM + j * 512 + lane * 8) = pk;
            }
        }
    };
    RES_LOAD(xnA, xnbA, ynA, r0);
    if (r0 + 1 < r1) RES_LOAD(xnB, xnbB, ynB, r0 + 1);
#pragma unroll 1
    for (int row = r0; row < r1; row += 2) {
        proc(xnA, xnbA, ynA, row, row + 2);
        if (row + 1 < r1) proc(xnB, xnbB, ynB, row + 1, row + 3);
    }
#undef RES_LOAD
#undef RES_V16
}

namespace pg8 {
#define PG8_LAS __attribute__((address_space(3)))
typedef unsigned short bf16_t;
typedef short bf16x8 __attribute__((ext_vector_type(8)));
typedef float f32x4 __attribute__((ext_vector_type(4)));
typedef unsigned u32x4 __attribute__((ext_vector_type(4)));
constexpr int BM = 256, BK = 64, HALF = 128, HTB = HALF * BK * 2  , STAGE_BYTES = 8 * HTB, NXCD = 8, WGM = 4;

__host__ __device__ __forceinline__ int lds_byte(int r, int c) { const int st = (r >> 4) * 2 + (c >> 5), rr = r & 15, cc = c & 31, ob = rr * 64 + cc * 2; return st * 1024 + (ob ^ (((ob >> 9) & 1) << 5)); }
__host__ __device__ __forceinline__ void stage_rc(int b, int& R, int& C) { const int st = b / 1024, sb = b % 1024, swz = sb ^ (((sb >> 9) & 1) << 5); R = (st >> 1) * 16 + swz / 64; C = (st & 1) * 32 + (swz % 64) / 2; }
__host__ __device__ __forceinline__ int perm32(int rho) { const int n = rho >> 4, i = rho & 15; return 8 * (i >> 2) + 4 * n + (i & 3); }

struct Unit { int pm, pn; };
struct Gemm { const bf16_t* A; const bf16_t* Bt; int M, N, K; };

struct StaticOrder {
    int nM, nN, nwg, G, c;
    __host__ __device__ void init(int M, int N, int G_, int c_) { nM = M / BM; nN = N / BM; nwg = nM * nN; G = G_; c = c_; }
    __host__ __device__ bool next(int i, Unit& u) const {
        const long L = (long)i * G + c; if (L >= nwg) return false;
        int wgid = (int)L; { const int q = nwg / NXCD, r = nwg % NXCD, xcd = wgid % NXCD, off = wgid / NXCD; wgid = (xcd < r ? xcd * (q + 1) : r * (q + 1) + (xcd - r) * q) + off; }
        const int nig = WGM * nN, gid = wgid / nig, fm = gid * WGM, gsz = (nM - fm) < WGM ? (nM - fm) : WGM;
        u.pm = fm + ((wgid % nig) % gsz); u.pn = (wgid % nig) / gsz; return true;
    }
    __device__ __forceinline__ void a_ready(const Unit&) const {}
    __device__ __forceinline__ void done(const Unit&) const {}
};
struct EpiPlain {
    static constexpr bool PERM = true, AFTER_DRAIN = false;
    u16* O; int ldc;
    __device__ __forceinline__ void operator()(const f32x4 (&acc)[2][2][4][2], const Unit& u, int wr, int wc, int fr, int fq) const {
        const int row0 = u.pm * BM + wr * 64 + fr, col0 = u.pn * BM + wc * 32 + 8 * fq;
#pragma unroll
        for (int ai = 0; ai < 2; ++ai)
#pragma unroll
            for (int m = 0; m < 4; ++m) {
                u16* rowp = O + (size_t)(row0 + ai * HALF + m * 16) * ldc + col0;
#pragma unroll
                for (int bj = 0; bj < 2; ++bj) {
                    const f32x4 v0 = acc[ai][bj][m][0], v1 = acc[ai][bj][m][1];
                    u32x4 w; w[0] = pk2(v0[0], v0[1]); w[1] = pk2(v0[2], v0[3]); w[2] = pk2(v1[0], v1[1]); w[3] = pk2(v1[2], v1[3]);
                    *(u32x4*)(rowp + bj * HALF) = w;
                }
            }
    }
};
struct EpiInProj {
    static constexpr bool PERM = true, AFTER_DRAIN = false;
    u16* P; u16* Q; u16* K; u16* Vt; const float* qg; const float* kg; const float* rope; bool last;
    __device__ __forceinline__ void operator()(const f32x4 (&acc)[2][2][4][2], const Unit& u, int wr, int wc, int fr, int fq) const {
        if (u.pn != 10 && u.pn != 11) {
            const int pn = u.pn;
            const int row0 = u.pm * BM + wr * 64 + fr;
            if (pn == 6 || pn == 9 || pn == 12) {
                const int seg = pn == 6 ? O_SBG : (pn == 9 ? O_CV : O_SDG);
                const bool act = pn != 9;
#pragma unroll
                for (int ai = 0; ai < 2; ++ai)
#pragma unroll
                    for (int m = 0; m < 4; ++m) {
                        u16* rowp = P + (size_t)(row0 + ai * HALF + m * 16) * PWO + seg + wc * 32 + 8 * fq;
#pragma unroll
                        for (int bj = 0; bj < 2; ++bj) {
                            f32x4 v0 = acc[ai][bj][m][0], v1 = acc[ai][bj][m][1];
                            if (act) {
#pragma unroll
                                for (int e = 0; e < 4; ++e) { v0[e] = siluf_(v0[e]); v1[e] = siluf_(v1[e]); }
                            }
                            u32x4 w; w[0] = pk2(v0[0], v0[1]); w[1] = pk2(v0[2], v0[3]); w[2] = pk2(v1[0], v1[1]); w[3] = pk2(v1[2], v1[3]);
                            *(u32x4*)(rowp + bj * HALF) = w;
                        }
                    }
                return;
            }
            const int seg = pn < 2 ? O_CX : (pn < 4 ? O_ABG : (pn < 6 ? O_Z : O_UG));
            const int half = pn < 6 ? (pn & 1) : ((pn - 7) & 1);
            const int op = pn < 2 ? 0 : ((pn == 4 || pn == 5) ? 2 : 1);
#pragma unroll
            for (int ai = 0; ai < 2; ++ai)
#pragma unroll
                for (int m = 0; m < 4; ++m) {
                    float o[8];
#pragma unroll
                    for (int n = 0; n < 2; ++n)
#pragma unroll
                        for (int e = 0; e < 4; ++e) {
                            const float x = acc[ai][0][m][n][e], y = acc[ai][1][m][n][e];
                            o[4 * n + e] = op == 0 ? x * y : (op == 1 ? x * siluf_(y) : x * sigmoidf_(y));
                        }
                    u32x4 w; w[0] = pk2(o[0], o[1]); w[1] = pk2(o[2], o[3]); w[2] = pk2(o[4], o[5]); w[3] = pk2(o[6], o[7]);
                    *(u32x4*)(P + (size_t)(row0 + ai * HALF + m * 16) * PWO + seg + half * 128 + wc * 32 + 8 * fq) = w;
                }
            return;
        }
        const int pm = u.pm;
        const bool lat = pm < NLAT / 256;
        const int b = lat ? (pm >> 5) : (pm - NLAT / 256);
        const int seq0 = lat ? b * SEQ : NLAT + b * CTX;
        const int rowb = pm * BM + wr * 64 + fr;
        if (u.pn == 11 && wc >= 2) {
            const int head = wc - 2;
            const int pfr = (fr & 3) | (((fr >> 3) & 1) << 2) | (((fr >> 2) & 1) << 3);
#pragma unroll
            for (int ai = 0; ai < 2; ++ai)
#pragma unroll
                for (int m = 0; m < 4; ++m) {
                    const int pos = rowb + ai * HALF + m * 16 - seq0 - fr;
                    const int tp = (lat ? CTX + pos : pos) + pfr;
#pragma unroll
                    for (int bj = 0; bj < 2; ++bj)
#pragma unroll
                        for (int n = 0; n < 2; ++n)
#pragma unroll
                            for (int e = 0; e < 4; ++e) {
                                const int d = 32 * bj + 16 * n + 4 * fq + e;
                                Vt[((size_t)(b * 2 + head) * 64 + d) * TKV + tp] = (u16)f2bf(acc[ai][bj][m][n][e]);
                            }
                }
            return;
        }
        const bool isq = (u.pn == 10);
        if (isq && last && !lat) return;
        const float* gp = isq ? qg : kg;
        const int head = wc;
        f32x4 g[2][2];
#pragma unroll
        for (int bj = 0; bj < 2; ++bj)
#pragma unroll
            for (int n = 0; n < 2; ++n) g[bj][n] = *(const f32x4*)(gp + 32 * bj + 16 * n + 4 * fq);
        const float osc = isq ? QSCALE : 1.f;
        u16* dst = isq ? Q + (size_t)(b * 4 + head) * TKV * 64 : K + (size_t)(b * 2 + head) * TKV * 64;
#pragma unroll
        for (int ai = 0; ai < 2; ++ai)
#pragma unroll
            for (int m = 0; m < 4; ++m) {
                const int pos = rowb + ai * HALF + m * 16 - seq0;
                const int tp = lat ? CTX + pos : pos;
                float ss = 0.f;
#pragma unroll
                for (int bj = 0; bj < 2; ++bj)
#pragma unroll
                    for (int n = 0; n < 2; ++n)
#pragma unroll
                        for (int e = 0; e < 4; ++e) ss += acc[ai][bj][m][n][e] * acc[ai][bj][m][n][e];
                ss += __shfl_xor(ss, 16); ss += __shfl_xor(ss, 32);
                const float rstd = rsqrtf(ss * (1.f / 64) + 1e-6f) ;
#pragma unroll
                for (int bj = 0; bj < 2; ++bj) {
                    f32x4 y1 = acc[ai][bj][m][0] * rstd * g[bj][0], y2 = acc[ai][bj][m][1] * rstd * g[bj][1];
                    f32x4 o1 = y1, o2 = y2;
                    if (lat) {
                        const int pp = bj == 0 ? (pos >> 6) : (pos & 63);
                        const f32x4 t0 = *(const f32x4*)(rope + (pp * 16 + 4 * fq) * 2), t1 = *(const f32x4*)(rope + (pp * 16 + 4 * fq) * 2 + 4);
                        const f32x4 cs = {t0[0], t0[2], t1[0], t1[2]}, sn = {t0[1], t0[3], t1[1], t1[3]};
                        o1 = y1 * cs - y2 * sn; o2 = y2 * cs + y1 * sn;
                    }
                    o1 = o1 * osc; o2 = o2 * osc;
                    u32x2 w1, w2; w1[0] = pk2(o1[0], o1[1]); w1[1] = pk2(o1[2], o1[3]); w2[0] = pk2(o2[0], o2[1]); w2[1] = pk2(o2[2], o2[3]);
                    *(u32x2*)(dst + (size_t)tp * 64 + 32 * bj + 4 * fq) = w1;
                    *(u32x2*)(dst + (size_t)tp * 64 + 32 * bj + 16 + 4 * fq) = w2;
                }
            }
    }
};

template <class Epi, class Sched, bool ALIGN_EPI = false, bool SP2 = false>
__device__ __forceinline__ void gemm_phase(PG8_LAS unsigned char* lds, const Gemm g, const Sched& S, const Epi& E) {
    const int tid = otid(), wid = __builtin_amdgcn_readfirstlane(tid >> 6), lane = tid & 63, wr = wid >> 2, wc = wid & 3, fr = lane & 15, fq = lane >> 4;
    const int K = g.K, nt = K / BK;
    unsigned voffA[2], voffB[2];
#pragma unroll
    for (int i = 0; i < 2; ++i) { int R, C; stage_rc(tid * 16 + i * 8192, R, C); const int Rb = Epi::PERM ? ((R & ~31) + perm32(R & 31)) : R;
        voffA[i] = (unsigned)(R * K + C) * 2u; voffB[i] = (unsigned)(Rb * K + C) * 2u; }
    const size_t kstep = (size_t)(BK * 2);
    const size_t hstep = (size_t)HALF * K * 2;
    const size_t tstep = 2 * hstep;
    const unsigned ldsw = (unsigned)wid * 1024u;
    const int aoff = lds_byte(wr * 64 + fr, fq * 8), boff = lds_byte(wc * 32 + fr, fq * 8);
#define PG8_SA(b, h) (((b) * 2 + (h)) * HTB)
#define PG8_SB(b, h) ((4 + (b) * 2 + (h)) * HTB)
#define PG8_STAGE(bufoff, gbase, voff) do { _Pragma("unroll") for (int _i = 0; _i < 2; ++_i) \
        __builtin_amdgcn_global_load_lds((const unsigned*)((const char*)(gbase) + (voff)[_i]), (PG8_LAS unsigned*)(lds + (bufoff) + ldsw + _i * 8192), 16, 0, 0); } while (0)
#define PG8_LDA(dst, b, h) do { _Pragma("unroll") for (int m = 0; m < 4; ++m) _Pragma("unroll") for (int k = 0; k < 2; ++k) dst[m][k] = *(const PG8_LAS bf16x8*)(lds + PG8_SA(b, h) + aoff + m * 2048 + k * 1024); } while (0)
#define PG8_LDB(dst, b, h) do { _Pragma("unroll") for (int n = 0; n < 2; ++n) _Pragma("unroll") for (int k = 0; k < 2; ++k) dst[n][k] = *(const PG8_LAS bf16x8*)(lds + PG8_SB(b, h) + boff + n * 2048 + k * 1024); } while (0)
#define PG8_MMA(ai, bj, At, Bt) do { __builtin_amdgcn_s_setprio(1); _Pragma("unroll") for (int m = 0; m < 4; ++m) _Pragma("unroll") for (int n = 0; n < 2; ++n) _Pragma("unroll") for (int k = 0; k < 2; ++k) \
        acc[ai][bj][m][n] = __builtin_amdgcn_mfma_f32_16x16x32_bf16(Bt[n][k], At[m][k], acc[ai][bj][m][n], 0, 0, 0); __builtin_amdgcn_s_setprio(0); } while (0)
#define PG8_WAIT_V(n) asm volatile("s_waitcnt vmcnt(" #n ")" ::: "memory")
#define PG8_WAIT_L(n) asm volatile("s_waitcnt lgkmcnt(" #n ")" ::: "memory")
#define PG8_BAR __builtin_amdgcn_s_barrier()
#define PG8_SCHED __builtin_amdgcn_sched_barrier(0)
    Unit cur, nxt; int ui = 0;
    if (!S.next(0, cur)) return;
    f32x4 acc[2][2][4][2];
#pragma unroll
    for (int a = 0; a < 2; ++a)
#pragma unroll
        for (int b = 0; b < 2; ++b)
#pragma unroll
            for (int m = 0; m < 4; ++m)
#pragma unroll
                for (int n = 0; n < 2; ++n) acc[a][b][m][n] = (f32x4){0.f, 0.f, 0.f, 0.f};
    bf16x8 At[4][2], B0[2][2], B1[2][2];
    const char* cA = (const char*)g.A + (size_t)cur.pm * tstep; const char* cB = (const char*)g.Bt + (size_t)cur.pn * tstep;
    S.a_ready(cur);
    if constexpr (SP2) {
        PG8_STAGE(PG8_SB(0, 0), cB, voffB); PG8_STAGE(PG8_SB(0, 1), cB + hstep, voffB); PG8_STAGE(PG8_SA(0, 0), cA, voffA); PG8_STAGE(PG8_SA(0, 1), cA + hstep, voffA);
        if (wr == 1) PG8_BAR;
        PG8_WAIT_V(2); PG8_BAR;
        PG8_STAGE(PG8_SB(1, 0), cB + kstep, voffB); PG8_STAGE(PG8_SA(1, 0), cA + kstep, voffA); PG8_STAGE(PG8_SB(1, 1), cB + hstep + kstep, voffB);
        PG8_WAIT_V(6); PG8_BAR;
    } else {
        PG8_STAGE(PG8_SB(0, 0), cB, voffB); PG8_STAGE(PG8_SA(0, 0), cA, voffA); PG8_STAGE(PG8_SB(0, 1), cB + hstep, voffB); PG8_STAGE(PG8_SA(0, 1), cA + hstep, voffA);
        if (wr == 1) PG8_BAR;
        PG8_WAIT_V(4); PG8_BAR;
        PG8_STAGE(PG8_SB(1, 0), cB + kstep, voffB); PG8_STAGE(PG8_SA(1, 0), cA + kstep, voffA); PG8_STAGE(PG8_SB(1, 1), cB + hstep + kstep, voffB);
        PG8_WAIT_V(6); PG8_BAR;
    }
    for (;;) {
        const bool has_next = S.next(ui + 1, nxt);
        const char* nA = has_next ? (const char*)g.A + (size_t)nxt.pm * tstep : cA; const char* nB = has_next ? (const char*)g.Bt + (size_t)nxt.pn * tstep : cB;
        for (int t = 0; t < nt; t += 2) {
            const bool last = (t == nt - 2);
            const char* a1 = cA + (size_t)(t + 1) * kstep;
            const char* a2 = last ? nA : cA + (size_t)(t + 2) * kstep; const char* b2 = last ? nB : cB + (size_t)(t + 2) * kstep;
            const char* a3 = a2 + kstep; const char* b3 = b2 + kstep;
            if (last && has_next) S.a_ready(nxt);
            if constexpr (SP2) {
            PG8_LDB(B0, 0, 0); PG8_LDB(B1, 0, 1); PG8_SCHED; PG8_LDA(At, 0, 0); PG8_STAGE(PG8_SA(1, 1), a1 + hstep, voffA);
            PG8_WAIT_V(8); PG8_WAIT_L(0); PG8_BAR; PG8_MMA(0, 0, At, B0); PG8_MMA(0, 1, At, B1); PG8_BAR; PG8_SCHED;
            PG8_LDA(At, 0, 1); PG8_STAGE(PG8_SB(0, 0), b2, voffB); PG8_STAGE(PG8_SB(0, 1), b2 + hstep, voffB); PG8_STAGE(PG8_SA(0, 0), a2, voffA);
            PG8_WAIT_V(8); PG8_WAIT_L(0); PG8_BAR; PG8_MMA(1, 0, At, B0); PG8_MMA(1, 1, At, B1); PG8_BAR; PG8_SCHED;
            PG8_LDB(B0, 1, 0); PG8_LDB(B1, 1, 1); PG8_SCHED; PG8_LDA(At, 1, 0); PG8_STAGE(PG8_SA(0, 1), a2 + hstep, voffA);
            PG8_WAIT_V(8); PG8_WAIT_L(0); PG8_BAR; PG8_MMA(0, 0, At, B0); PG8_MMA(0, 1, At, B1); PG8_BAR; PG8_SCHED;
            PG8_LDA(At, 1, 1); PG8_STAGE(PG8_SB(1, 0), b3, voffB); PG8_STAGE(PG8_SB(1, 1), b3 + hstep, voffB); PG8_STAGE(PG8_SA(1, 0), a3, voffA);
            PG8_WAIT_V(8); PG8_WAIT_L(0); PG8_BAR; PG8_MMA(1, 0, At, B0); PG8_MMA(1, 1, At, B1); PG8_BAR; PG8_SCHED;
            } else {
            PG8_LDB(B0, 0, 0); PG8_SCHED; PG8_LDA(At, 0, 0); PG8_STAGE(PG8_SA(1, 1), a1 + hstep, voffA);
            PG8_WAIT_L(8); PG8_BAR; PG8_WAIT_L(0); PG8_MMA(0, 0, At, B0); PG8_BAR; PG8_SCHED;
            PG8_LDB(B1, 0, 1); PG8_STAGE(PG8_SB(0, 0), b2, voffB);
            PG8_BAR; PG8_WAIT_L(0); PG8_MMA(0, 1, At, B1); PG8_BAR;
            PG8_LDA(At, 0, 1); PG8_STAGE(PG8_SA(0, 0), a2, voffA);
            PG8_BAR; PG8_WAIT_L(0); PG8_MMA(1, 0, At, B0); PG8_BAR; PG8_SCHED;
            PG8_STAGE(PG8_SB(0, 1), b2 + hstep, voffB);
            PG8_WAIT_V(6); PG8_BAR; PG8_MMA(1, 1, At, B1); PG8_BAR;
            PG8_LDB(B0, 1, 0); PG8_SCHED; PG8_LDA(At, 1, 0); PG8_STAGE(PG8_SA(0, 1), a2 + hstep, voffA);
            PG8_WAIT_L(8); PG8_BAR; PG8_WAIT_L(0); PG8_MMA(0, 0, At, B0); PG8_BAR; PG8_SCHED;
            PG8_LDB(B1, 1, 1); PG8_STAGE(PG8_SB(1, 0), b3, voffB);
            PG8_BAR; PG8_WAIT_L(0); PG8_MMA(0, 1, At, B1); PG8_BAR;
            PG8_LDA(At, 1, 1); PG8_STAGE(PG8_SA(1, 0), a3, voffA);
            PG8_BAR; PG8_WAIT_L(0); PG8_MMA(1, 0, At, B0); PG8_BAR; PG8_SCHED;
            PG8_STAGE(PG8_SB(1, 1), b3 + hstep, voffB);
            PG8_WAIT_V(6); PG8_BAR; PG8_MMA(1, 1, At, B1); PG8_BAR;
            }
        }
        if constexpr (ALIGN_EPI) { if (wr == 0) PG8_BAR; }
        if constexpr (!Epi::AFTER_DRAIN) { E(acc, cur, wr, wc, fr, fq); S.done(cur); }
        if (!has_next) break;
#pragma unroll
        for (int a = 0; a < 2; ++a)
#pragma unroll
            for (int b = 0; b < 2; ++b)
#pragma unroll
                for (int m = 0; m < 4; ++m)
#pragma unroll
                    for (int n = 0; n < 2; ++n) acc[a][b][m][n] = (f32x4){0.f, 0.f, 0.f, 0.f};
        cur = nxt; cA = nA; cB = nB; ++ui;
        if constexpr (ALIGN_EPI) { if (wr == 1) PG8_BAR; }
    }
    PG8_WAIT_V(0);
    if constexpr (!ALIGN_EPI) { if (wr == 0) PG8_BAR; }
    PG8_BAR;
    if constexpr (Epi::AFTER_DRAIN) { E.fused(acc, cur, wr, wc, fr, fq, lds, wid, lane); S.done(cur); }
#undef PG8_SA
#undef PG8_SB
#undef PG8_STAGE
#undef PG8_LDA
#undef PG8_LDB
#undef PG8_MMA
#undef PG8_WAIT_V
#undef PG8_WAIT_L
#undef PG8_BAR
#undef PG8_SCHED
}
}

DI void tok_item(const Params& p, int l, int item, unsigned char* lds) {
    const int tid = otid(), lane = tid & 63, wid = tid >> 6;
    const int R0 = item * 64;
    const bool lat = R0 < NLAT;
    int seq_start, seq_end;
    if (lat) { const int b = R0 / SEQ; seq_start = b * SEQ; seq_end = seq_start + SEQ; }
    else { const int b = (R0 - NLAT) / CTX; seq_start = NLAT + b * CTX; seq_end = seq_start + CTX; }
    const u16* P = (const u16*)(p.ws + WS_P);
    u16* YM = (u16*)(p.ws + WS_YMIX);
    u16* zl = (u16*)lds;
    float* cvo = (float*)(lds + 48128);
    const u32x4 zero4 = {0u, 0u, 0u, 0u};
    u32x4 zv[6];
#pragma unroll
    for (int j = 0; j < 6; ++j) {
        const int ci = j * NTHREADS + tid, zr = ci >> 5, c8 = (ci & 31) * 8, row = R0 - 15 + zr;
        zv[j] = (ci < 94 * 32 && row >= seq_start && row < seq_end) ? *(const u32x4*)(P + (size_t)row * PWO + O_Z + c8) : zero4;
    }
    const int cp = tid & 127, qt = tid >> 7;
    float w0[31], w1[31];
    {
        const float* wb = p.conv_b + (size_t)l * 31 * 256 + cp * 2;
#pragma unroll
        for (int k = 0; k < 31; ++k) { const f32x2_t w2 = *(const f32x2_t*)(wb + k * 256); w0[k] = w2[0]; w1[k] = w2[1]; }
    }
    const float bias0 = p.conv_b_bias[l * 256 + cp * 2], bias1 = p.conv_b_bias[l * 256 + cp * 2 + 1];
    u32x4 cv[4][3], bv[4];
#pragma unroll
    for (int j = 0; j < 4; ++j) {
        const int ci = j * NTHREADS + tid, tl = ci >> 5, c8 = (ci & 31) * 8, row = R0 + tl;
#pragma unroll
        for (int k = 0; k < 3; ++k) {
            const int rr = row + k - 1;
            cv[j][k] = (rr >= seq_start && rr < seq_end) ? *(const u32x4*)(P + (size_t)rr * PWO + O_CX + c8) : zero4;
        }
        bv[j] = *(const u32x4*)(P + (size_t)row * PWO + O_ABG + c8);
    }
    const int sub = lane & 15, t4 = lane >> 4, ch = sub * 16;
    u32x4 gr[2][2];
#pragma unroll
    for (int i = 0; i < 2; ++i) {
        const int row = R0 + wid * 8 + i * 4 + t4;
        gr[i][0] = *(const u32x4*)(P + (size_t)row * PWO + O_SBG + ch);
        gr[i][1] = *(const u32x4*)(P + (size_t)row * PWO + O_SBG + ch + 8);
    }
#pragma unroll
    for (int j = 0; j < 6; ++j) {
        const int ci = j * NTHREADS + tid, zr = ci >> 5, c8 = (ci & 31) * 8;
        if (ci < 94 * 32) *(u32x4*)(zl + zr * 256 + c8) = zv[j];
    }
    __syncthreads();
    {
#pragma unroll 1
        for (int ps = 0; ps < 2; ++ps) {
            float a0[8], a1[8];
#pragma unroll
            for (int o = 0; o < 8; ++o) { a0[o] = bias0; a1[o] = bias1; }
            const u16* zb = zl + (qt * 16 + ps * 8) * 256 + cp * 2;
#pragma unroll
            for (int i = 0; i < 38; ++i) {
                const unsigned zz = *(const unsigned*)(zb + i * 256);
                const float z0 = bflo(zz), z1 = bfhi(zz);
#pragma unroll
                for (int o = 0; o < 8; ++o) {
                    const int k = i - o;
                    if (k >= 0 && k < 31) { a0[o] += z0 * w0[k]; a1[o] += z1 * w1[k]; }
                }
            }
#pragma unroll
            for (int o = 0; o < 8; ++o) { cvo[(qt * 16 + ps * 8 + o) * 256 + cp * 2] = a0[o]; cvo[(qt * 16 + ps * 8 + o) * 256 + cp * 2 + 1] = a1[o]; }
        }
    }
    {
        const float* wa = p.conv_a + (size_t)l * 3 * 256;
#pragma unroll
        for (int j = 0; j < 4; ++j) {
            const int ci = j * NTHREADS + tid, tl = ci >> 5, c8 = (ci & 31) * 8, row = R0 + tl;
            float acc[8];
#pragma unroll
            for (int e = 0; e < 8; ++e) acc[e] = 0.f;
#pragma unroll
            for (int k = 0; k < 3; ++k) {
                float cf[8]; unpack8(cv[j][k], cf);
                const f32x4 wk0 = *(const f32x4*)(wa + k * 256 + c8), wk1 = *(const f32x4*)(wa + k * 256 + c8 + 4);
#pragma unroll
                for (int e = 0; e < 4; ++e) { acc[e] += cf[e] * wk0[e]; acc[4 + e] += cf[4 + e] * wk1[e]; }
            }
            float bf[8]; unpack8(bv[j], bf);
            u32x4 o;
#pragma unroll
            for (int e = 0; e < 4; ++e) o[e] = pk2(bf[2 * e] * acc[2 * e], bf[2 * e + 1] * acc[2 * e + 1]);
            *(u32x4*)(YM + (size_t)row * DM + c8) = o;
        }
    }
    __syncthreads();
    {
        const float* lg = p.conf_ln_g + l * 256 + ch;
        const float* lb = p.conf_ln_b + l * 256 + ch;
#pragma unroll
        for (int i = 0; i < 2; ++i) {
            const int tl = wid * 8 + i * 4 + t4, row = R0 + tl;
            float v[16];
#pragma unroll
            for (int q = 0; q < 4; ++q) { const f32x4 t = *(const f32x4*)(cvo + tl * 256 + ch + q * 4); v[4 * q] = t[0]; v[4 * q + 1] = t[1]; v[4 * q + 2] = t[2]; v[4 * q + 3] = t[3]; }
            float sm = 0.f;
#pragma unroll
            for (int e = 0; e < 16; ++e) sm += v[e];
            sm += __shfl_xor(sm, 1); sm += __shfl_xor(sm, 2); sm += __shfl_xor(sm, 4); sm += __shfl_xor(sm, 8);
            const float mu = sm * (1.f / 256);
            float sq = 0.f;
#pragma unroll
            for (int e = 0; e < 16; ++e) { v[e] -= mu; sq += v[e] * v[e]; }
            sq += __shfl_xor(sq, 1); sq += __shfl_xor(sq, 2); sq += __shfl_xor(sq, 4); sq += __shfl_xor(sq, 8);
            const float rstd = rsqrtf(sq * (1.f / 256) + 1e-5f);
            float g[16]; unpack8(gr[i][0], g); unpack8(gr[i][1], g + 8);
            u32x4 o[2];
#pragma unroll
            for (int e = 0; e < 8; ++e) {
                const float y0 = v[2 * e] * rstd * lg[2 * e] + lb[2 * e], y1 = v[2 * e + 1] * rstd * lg[2 * e + 1] + lb[2 * e + 1];
                o[e >> 2][e & 3] = pk2(siluf_(y0) * g[2 * e], siluf_(y1) * g[2 * e + 1]);
            }
            *(u32x4*)(YM + (size_t)row * DM + 256 + ch) = o[0];
            *(u32x4*)(YM + (size_t)row * DM + 256 + ch + 8) = o[1];
        }
    }
    __syncthreads();
}

DI void chunk_item(const Params& p, int l, int item, unsigned char* lds) {
    const int tid = otid(), lane = tid & 63, wid = tid >> 6, r = lane & 31, h = lane >> 5;
    const int R0 = item * 128;
    const u16* P = (const u16*)(p.ws + WS_P);
    u16* YM = (u16*)(p.ws + WS_YMIX);
    unsigned char* vt = lds;
    float* part = (float*)(lds + 256 * 272);
    unsigned char* dl = lds + 256 * 272 + 4096;
    {
        const int g = tid >> 7, j = tid & 127;
        const u16* src = P + (size_t)(R0 + j) * PWO + O_CV + g * 64;
        float x[64];
#pragma unroll
        for (int i = 0; i < 8; ++i) { const u32x4 v = *(const u32x4*)(src + i * 8); unpack8(v, x + i * 8); }
        float s = 0, s2 = 0;
#pragma unroll
        for (int i = 0; i < 64; ++i) { s += x[i]; s2 += x[i] * x[i]; }
        part[(g * 128 + j) * 2] = s; part[(g * 128 + j) * 2 + 1] = s2;
        __syncthreads();
        float ts = 0, ts2 = 0;
#pragma unroll
        for (int gg = 0; gg < 4; ++gg) { ts += part[(gg * 128 + j) * 2]; ts2 += part[(gg * 128 + j) * 2 + 1]; }
        const float mu = ts * (1.f / 256);
        const float var = fmaxf(ts2 * (1.f / 256) - mu * mu, 0.f);
        const float rstd = rsqrtf(var + 1e-5f);
        const float* lg = p.sgu_ln_g + l * 256 + g * 64;
        const float* lb = p.sgu_ln_b + l * 256 + g * 64;
#pragma unroll
        for (int i = 0; i < 64; ++i) {
            const float y = (x[i] - mu) * rstd * lg[i] + lb[i];
            *(u16*)(vt + (g * 64 + i) * 272 + j * 2) = (u16)f2bf(y);
        }
    }
    __syncthreads();
    {
        const int g = wid >> 1, half = wid & 1;
        const u16* W = (const u16*)(p.ws + WS_WSBF) + (size_t)(l * 4 + g) * 128 * 128;
        bf16x8 wf[2][8];
#pragma unroll
        for (int ib = 0; ib < 2; ++ib)
#pragma unroll
            for (int s = 0; s < 8; ++s) wf[ib][s] = *(const bf16x8*)(W + ((half * 2 + ib) * 32 + r) * 128 + 16 * s + 8 * h);
        f32x16 acc[2][2];
#pragma unroll
        for (int ib = 0; ib < 2; ++ib)
#pragma unroll
            for (int cb = 0; cb < 2; ++cb)
#pragma unroll
                for (int e = 0; e < 16; ++e) acc[ib][cb][e] = 0.f;
#pragma unroll
        for (int cb = 0; cb < 2; ++cb)
#pragma unroll
            for (int s = 0; s < 8; ++s) {
                const bf16x8 vf = *(const bf16x8*)(vt + (g * 64 + cb * 32 + r) * 272 + (16 * s + 8 * h) * 2);
#pragma unroll
                for (int ib = 0; ib < 2; ++ib) acc[ib][cb] = MFMA32(vf, wf[ib][s], acc[ib][cb]);
            }
        const float* bs = p.b_s + (l * 4 + g) * 128;
#pragma unroll
        for (int ib = 0; ib < 2; ++ib) {
            const int i = (half * 2 + ib) * 32 + r;
            const float bias = bs[i];
#pragma unroll
            for (int cb = 0; cb < 2; ++cb)
#pragma unroll
                for (int q = 0; q < 4; ++q) {
                    u32x2 pk;
                    pk[0] = pk2(acc[ib][cb][4 * q] + bias, acc[ib][cb][4 * q + 1] + bias);
                    pk[1] = pk2(acc[ib][cb][4 * q + 2] + bias, acc[ib][cb][4 * q + 3] + bias);
                    *(u32x2*)(dl + i * 520 + (g * 64 + cb * 32 + 8 * q + 4 * h) * 2) = pk;
                }
        }
    }
    __syncthreads();
#pragma unroll 1
    for (int base = 0; base < 128 * 32; base += 4 * NTHREADS) {
        u32x4 uv[4];
#pragma unroll
        for (int j = 0; j < 4; ++j) {
            const int ci = base + j * NTHREADS + tid, i = ci >> 5, c8 = (ci & 31) * 8;
            uv[j] = *(const u32x4*)(P + (size_t)(R0 + i) * PWO + O_UG + c8);
        }
#pragma unroll
        for (int j = 0; j < 4; ++j) {
            const int ci = base + j * NTHREADS + tid, i = ci >> 5, c8 = (ci & 31) * 8;
            const u32x2 d0 = *(const u32x2*)(dl + i * 520 + c8 * 2), d1 = *(const u32x2*)(dl + i * 520 + c8 * 2 + 8);
            u32x4 dv; dv[0] = d0[0]; dv[1] = d0[1]; dv[2] = d1[0]; dv[3] = d1[1];
            float uf[8], df[8]; unpack8(uv[j], uf); unpack8(dv, df);
            u32x4 o;
#pragma unroll
            for (int e = 0; e < 4; ++e) o[e] = pk2(uf[2 * e] * df[2 * e], uf[2 * e + 1] * df[2 * e + 1]);
            *(u32x4*)(YM + (size_t)(R0 + i) * DM + 512 + c8) = o;
        }
    }
    __syncthreads();
}

DI void phase_tokens(const Params& p, int l, unsigned char* lds) {
    const bool last = (l == DEPTH - 1);
    const int n_tok = (last ? NLAT : NROWS) / 64;
    const int n_chunk = (last ? NLAT : NROWS) / 128;
    unsigned* ctr = (unsigned*)(p.ws + WS_CTR) + 16 * l;
    volatile unsigned* slot = (volatile unsigned*)(lds + LDS_BYTES - 16);
    const int tid = otid();
    for (;;) {
        if (tid == 0) *slot = atomicAdd(ctr, 1u);
        __syncthreads();
        const int it = (int)*slot;
        __syncthreads();
        if (it >= n_tok + n_chunk) break;
        if (it < n_chunk) chunk_item(p, l, it, lds);
        else tok_item(p, l, it - n_chunk, lds);
    }
}

template <bool FAST>
DI void attn_unit(const Params& p, int b, int kvh, int q0, int nt, unsigned char* lds) {
    const int tid = otid(), lane = tid & 63, wid = tid >> 6, r = lane & 31, h = lane >> 5;
    const int head = 2 * kvh + (wid >> 2);
    const int qpos = q0 + (wid & 3) * 32 + r;
    const u16* Qg = (const u16*)(p.ws + WS_Q) + ((size_t)(b * 4 + head) * TKV + qpos) * 64;
    const u16* Kg = (const u16*)(p.ws + WS_K) + (size_t)(b * 2 + kvh) * TKV * 64;
    const u16* Vg = (const u16*)(p.ws + WS_VT) + (size_t)(b * 2 + kvh) * 64 * TKV;
    bf16x8 qf[4];
#pragma unroll
    for (int s = 0; s < 4; ++s) qf[s] = *(const bf16x8*)(Qg + 16 * s + 8 * h);
    f32x16 oacc[2];
#pragma unroll
    for (int e = 0; e < 16; ++e) { oacc[0][e] = 0.f; oacc[1][e] = 0.f; }
    float m_run = -1e30f, l_run = 0.f;
    const int lrow = tid >> 3, lch = tid & 7;
    const int woff = swz(lrow, lch);
    u32x4 kr, vr;
    kr = *(const u32x4*)(Kg + (size_t)lrow * 64 + lch * 8);
    vr = *(const u32x4*)(Vg + (size_t)lrow * TKV + lch * 8);
    *(u32x4*)(lds + woff) = kr;
    *(u32x4*)(lds + 8192 + woff) = vr;
    if (nt > 1) {
        kr = *(const u32x4*)(Kg + (size_t)(64 + lrow) * 64 + lch * 8);
        vr = *(const u32x4*)(Vg + (size_t)lrow * TKV + 64 + lch * 8);
    }
    __syncthreads();
    for (int t = 0; t < nt; ++t) {
        unsigned char* cur = lds + (t & 1) * 16384;
        unsigned char* nxt = lds + ((t + 1) & 1) * 16384;
        if (t + 1 < nt) {
            *(u32x4*)(nxt + woff) = kr;
            *(u32x4*)(nxt + 8192 + woff) = vr;
        }
        if (t + 2 < nt) {
            kr = *(const u32x4*)(Kg + (size_t)((t + 2) * 64 + lrow) * 64 + lch * 8);
            vr = *(const u32x4*)(Vg + (size_t)lrow * TKV + (t + 2) * 64 + lch * 8);
        }
        f32x16 sacc[2];
#pragma unroll
        for (int kb = 0; kb < 2; ++kb) {
#pragma unroll
            for (int e = 0; e < 16; ++e) sacc[kb][e] = 0.f;
#pragma unroll
            for (int s = 0; s < 4; ++s) {
                const bf16x8 kf = *(const bf16x8*)(cur + swz(kb * 32 + r, 2 * s + h));
                sacc[kb] = MFMA32(kf, qf[s], sacc[kb]);
            }
        }
        float m_new = 0.f;
        if (!FAST) {
            float mx = sacc[0][0];
#pragma unroll
            for (int e = 1; e < 16; ++e) mx = fmaxf(mx, sacc[0][e]);
#pragma unroll
            for (int e = 0; e < 16; ++e) mx = fmaxf(mx, sacc[1][e]);
            mx = fmaxf(mx, __shfl_xor(mx, 32));
            m_new = fmaxf(m_run, mx);
            const float alpha = __builtin_amdgcn_exp2f(m_run - m_new);
            m_run = m_new;
            l_run *= alpha;
#pragma unroll
            for (int e = 0; e < 16; ++e) { oacc[0][e] *= alpha; oacc[1][e] *= alpha; }
        }
        bf16x8 pf[2][2];
#pragma unroll
        for (int kb = 0; kb < 2; ++kb)
#pragma unroll
            for (int s2 = 0; s2 < 2; ++s2) {
                u32x4 pk;
#pragma unroll
                for (int e = 0; e < 4; ++e) {
                    float s0 = sacc[kb][8 * s2 + 2 * e], s1 = sacc[kb][8 * s2 + 2 * e + 1];
                    if (!FAST) { s0 -= m_new; s1 -= m_new; }
                    const float p0 = __builtin_amdgcn_exp2f(s0), p1 = __builtin_amdgcn_exp2f(s1);
                    l_run += p0; l_run += p1;
                    pk[e] = pk2(p0, p1);
                }
                pf[kb][s2] = __builtin_bit_cast(bf16x8, pk);
            }
#pragma unroll
        for (int db = 0; db < 2; ++db)
#pragma unroll
            for (int kb = 0; kb < 2; ++kb)
#pragma unroll
                for (int s2 = 0; s2 < 2; ++s2) {
                    const bf16x8 vf = *(const bf16x8*)(cur + 8192 + swz(db * 32 + r, kb * 4 + 2 * s2 + h));
                    oacc[db] = MFMA32(vf, pf[kb][s2], oacc[db]);
                }
        __syncthreads();
    }
    const float l_tot = l_run + __shfl_xor(l_run, 32);
    const float inv = 1.f / l_tot;
    const int row = (qpos >= CTX) ? b * SEQ + (qpos - CTX) : NLAT + b * CTX + qpos;
    const u16* P = (const u16*)(p.ws + WS_P) + (size_t)row * PWO + O_SDG + head * 64;
    u16* YM = (u16*)(p.ws + WS_YMIX) + (size_t)row * DM + 768 + head * 64;
#pragma unroll
    for (int db = 0; db < 2; ++db)
#pragma unroll
        for (int g = 0; g < 4; ++g) {
            const int d = db * 32 + 8 * g + 4 * h;
            const u32x2 gr = *(const u32x2*)(P + d);
            float gf[4]; unpack4(gr, gf);
            float o[4];
#pragma unroll
            for (int e = 0; e < 4; ++e) o[e] = oacc[db][4 * g + e] * inv * gf[e];
            u32x2 pk; pk[0] = pk2(o[0], o[1]); pk[1] = pk2(o[2], o[3]);
            *(u32x2*)(YM + d) = pk;
        }
}
DI void attn_unit_pipe(const Params& p, int b, int kvh, int q0, int nt, unsigned char* lds) {
    const int tid = otid(), lane = tid & 63, wid = tid >> 6, r = lane & 31, h = lane >> 5;
    const int head = 2 * kvh + (wid >> 2);
    const int qpos = q0 + (wid & 3) * 32 + r;
    const u16* Qg = (const u16*)(p.ws + WS_Q) + ((size_t)(b * 4 + head) * TKV + qpos) * 64;
    const u16* Kg = (const u16*)(p.ws + WS_K) + (size_t)(b * 2 + kvh) * TKV * 64;
    const u16* Vg = (const u16*)(p.ws + WS_VT) + (size_t)(b * 2 + kvh) * 64 * TKV;
    bf16x8 qf[4];
#pragma unroll
    for (int s = 0; s < 4; ++s) qf[s] = *(const bf16x8*)(Qg + 16 * s + 8 * h);
    f32x16 oacc[2], lacc, S0[2], S1[2];
#pragma unroll
    for (int e = 0; e < 16; ++e) { oacc[0][e] = 0.f; oacc[1][e] = 0.f; lacc[e] = 0.f; }
    bf16x8 ones;
#pragma unroll
    for (int e = 0; e < 8; ++e) ones[e] = (short)0x3F80;
    const int lrow = tid >> 3, lch = tid & 7;
    const int woff = swz(lrow, lch);
    const u16* Kl = Kg + (size_t)lrow * 64 + lch * 8;
    const u16* Vl = Vg + (size_t)lrow * TKV + lch * 8;
    unsigned char* KB = lds;
    unsigned char* VB = lds + 16384;
    u32x4 kr, vr;
    {
        const u32x4 k0 = *(const u32x4*)(Kl), v0 = *(const u32x4*)(Vl), k1 = *(const u32x4*)(Kl + 4096);
        *(u32x4*)(KB + woff) = k0; *(u32x4*)(VB + woff) = v0; *(u32x4*)(KB + 8192 + woff) = k1;
        const int t2 = 2 < nt ? 2 : nt - 1;
        kr = *(const u32x4*)(Kl + (size_t)t2 * 4096); vr = *(const u32x4*)(Vl + 64);
    }
    __syncthreads();
#pragma unroll
    for (int kb = 0; kb < 2; ++kb) {
#pragma unroll
        for (int e = 0; e < 16; ++e) S0[kb][e] = 0.f;
#pragma unroll
        for (int s = 0; s < 4; ++s) S0[kb] = MFMA32(*(const bf16x8*)(KB + swz(kb * 32 + r, 2 * s + h)), qf[s], S0[kb]);
    }
    __syncthreads();
#define ATT_STEP(SC, SN, T) do { \
        const int t_ = (T); \
        unsigned char* kw = KB + (t_ & 1) * 8192; unsigned char* vw = VB + ((t_ + 1) & 1) * 8192; \
        *(u32x4*)(kw + woff) = kr; *(u32x4*)(vw + woff) = vr; \
        { const int tk = t_ + 3 < nt ? t_ + 3 : nt - 1, tv = t_ + 2 < nt ? t_ + 2 : nt - 1; \
          kr = *(const u32x4*)(Kl + (size_t)tk * 4096); vr = *(const u32x4*)(Vl + tv * 64); } \
        const unsigned char* kc = KB + ((t_ + 1) & 1) * 8192; const unsigned char* vc = VB + (t_ & 1) * 8192; \
        bf16x8 kf[8], vf[8]; \
        _Pragma("unroll") for (int i = 0; i < 8; ++i) kf[i] = *(const bf16x8*)(kc + swz((i >> 2) * 32 + r, 2 * (i & 3) + h)); \
        _Pragma("unroll") for (int i = 0; i < 8; ++i) vf[i] = *(const bf16x8*)(vc + swz((i & 1) * 32 + r, (i >> 1) * 2 + h)); \
        __builtin_amdgcn_sched_barrier(0); \
        bf16x8 pf[2][2]; \
        _Pragma("unroll") for (int kb = 0; kb < 2; ++kb) { \
            _Pragma("unroll") for (int e = 0; e < 16; ++e) SN[kb][e] = 0.f; \
            _Pragma("unroll") for (int s = 0; s < 4; ++s) { \
                SN[kb] = MFMA32(kf[kb * 4 + s], qf[s], SN[kb]); \
                const float e0 = __builtin_amdgcn_exp2f(SC[kb][4 * s]), e1 = __builtin_amdgcn_exp2f(SC[kb][4 * s + 1]); \
                const float e2 = __builtin_amdgcn_exp2f(SC[kb][4 * s + 2]), e3 = __builtin_amdgcn_exp2f(SC[kb][4 * s + 3]); \
                u32x4 t4 = __builtin_bit_cast(u32x4, pf[kb][s >> 1]); \
                t4[(s & 1) * 2] = pk2(e0, e1); t4[(s & 1) * 2 + 1] = pk2(e2, e3); \
                pf[kb][s >> 1] = __builtin_bit_cast(bf16x8, t4); \
            } \
        } \
        _Pragma("unroll") for (int kb = 0; kb < 2; ++kb) \
            _Pragma("unroll") for (int s2 = 0; s2 < 2; ++s2) { \
                _Pragma("unroll") for (int db = 0; db < 2; ++db) \
                    oacc[db] = MFMA32(vf[(kb * 2 + s2) * 2 + db], pf[kb][s2], oacc[db]); \
                lacc = MFMA32(ones, pf[kb][s2], lacc); \
            } \
        __syncthreads(); \
    } while (0)
    int t = 0;
    for (; t + 2 <= nt - 1; t += 2) { ATT_STEP(S0, S1, t); ATT_STEP(S1, S0, t + 1); }
    if (t < nt - 1) {
        ATT_STEP(S0, S1, t);
#pragma unroll
        for (int kb = 0; kb < 2; ++kb) S0[kb] = S1[kb];
    }
#undef ATT_STEP
    {
        const unsigned char* vc = VB + ((nt - 1) & 1) * 8192;
#pragma unroll
        for (int kb = 0; kb < 2; ++kb)
#pragma unroll
            for (int s2 = 0; s2 < 2; ++s2) {
                u32x4 pk;
#pragma unroll
                for (int e = 0; e < 4; ++e) pk[e] = pk2(__builtin_amdgcn_exp2f(S0[kb][8 * s2 + 2 * e]), __builtin_amdgcn_exp2f(S0[kb][8 * s2 + 2 * e + 1]));
                const bf16x8 pfr = __builtin_bit_cast(bf16x8, pk);
#pragma unroll
                for (int db = 0; db < 2; ++db)
                    oacc[db] = MFMA32(*(const bf16x8*)(vc + swz(db * 32 + r, kb * 4 + 2 * s2 + h)), pfr, oacc[db]);
                lacc = MFMA32(ones, pfr, lacc);
            }
    }
    __syncthreads();
    const float inv = 1.f / lacc[0];
    const int row = (qpos >= CTX) ? b * SEQ + (qpos - CTX) : NLAT + b * CTX + qpos;
    const u16* P = (const u16*)(p.ws + WS_P) + (size_t)row * PWO + O_SDG + head * 64;
    u16* YM = (u16*)(p.ws + WS_YMIX) + (size_t)row * DM + 768 + head * 64;
#pragma unroll
    for (int db = 0; db < 2; ++db)
#pragma unroll
        for (int g = 0; g < 4; ++g) {
            const int d = db * 32 + 8 * g + 4 * h;
            const u32x2 gr = *(const u32x2*)(P + d);
            float gf[4]; unpack4(gr, gf);
            float o[4];
#pragma unroll
            for (int e = 0; e < 4; ++e) o[e] = oacc[db][4 * g + e] * inv * gf[e];
            u32x2 pk; pk[0] = pk2(o[0], o[1]); pk[1] = pk2(o[2], o[3]);
            *(u32x2*)(YM + d) = pk;
        }
}
template <bool FAST>
DI void attn_units(const Params& p, int nunits, unsigned char* lds) {
    for (int u = vbid(); u < nunits; u += gridDim.x) {
        int b, kvh, q0, nt;
        if (u < 512) { b = u >> 7; kvh = (u >> 6) & 1; q0 = CTX + (u & 63) * 128; nt = TKV / 64; }
        else { const int v = u - 512; b = v >> 2; kvh = (v >> 1) & 1; q0 = (v & 1) * 128; nt = CTX / 64; }
        if (FAST) attn_unit_pipe(p, b, kvh, q0, nt, lds); else attn_unit<false>(p, b, kvh, q0, nt, lds);
    }
}
DI void phase_attn(const Params& p, int l, unsigned char* lds) {
    const bool last = (l == DEPTH - 1);
    const int nunits = 512 + (last ? 0 : 16);
    const int lane = otid() & 63;
    float qm = fabsf(p.q_gain[l * 64 + lane]), km = fabsf(p.k_gain[l * 64 + lane]);
#pragma unroll
    for (int o = 1; o < 64; o <<= 1) { qm = fmaxf(qm, __shfl_xor(qm, o)); km = fmaxf(km, __shfl_xor(km, o)); }
    const float bound = QSCALE * 64.f * qm * km;
    if (bound < 30.f) attn_units<true>(p, nunits, lds);
    else attn_units<false>(p, nunits, lds);
}

struct OneTile {
    int pm, pn;
    __device__ __forceinline__ bool next(int i, pg8::Unit& u) const { if (i) return false; u.pm = pm; u.pn = pn; return true; }
    __device__ __forceinline__ void a_ready(const pg8::Unit&) const {}
    __device__ __forceinline__ void done(const pg8::Unit&) const {}
};
DI void phase_residual(const Params& p, int l, unsigned char* lds) {
    const int tid = otid(), wid = tid >> 6, bid = obid(), G = (int)gridDim.x;
    const bool last = (l == DEPTH - 1);
    const int nctx = (!last && G > 32) ? 16 : 0;
    if (bid >= G - nctx) {
        const int u = bid - (G - nctx), panel = u >> 2, pn = u & 3;
        pg8::Gemm g{(const u16*)(p.ws + WS_YMIX), (const u16*)(p.ws + WS_WTOUT) + (size_t)l * DM * DM, NROWS, DM, DM};
        OneTile S{NLAT / 256 + panel, pn};
        pg8::EpiPlain E{(u16*)(p.ws + WS_H), DM};
        pg8::gemm_phase<pg8::EpiPlain, OneTile, false, true>((PG8_LAS unsigned char*)lds, g, S, E);
        grid_barrier((unsigned*)(p.ws + WS_PANEL) + 16 * (l * 4 + panel), 4u);
        const int rb = NLAT + panel * 256 + pn * 64 + wid * 8;
        residual_rows(p, l, rb, rb + 8);
    } else {
        const int nw = (G - nctx) * 8, gw = bid * 8 + wid;
        const int nrows = (last || nctx) ? NLAT : NROWS;
        const int rpw = (nrows + nw - 1) / nw;
        const int r0 = gw * rpw, r1 = (r0 + rpw < nrows) ? r0 + rpw : nrows;
        residual_rows(p, l, r0, r1);
    }
}

constexpr int PPL = 4;
constexpr int N_PHASES = 2 + PPL * DEPTH;
DI void run_phase(const Params& p, int ph, unsigned char* lds) {
#ifndef ONLY
#define ONLY -1
#endif
    if (ph == 0) { if (ONLY < 0 || ONLY == 0) phase_prologue(p, lds); return; }
    if (ph == 1) { if (ONLY < 0 || ONLY == 1) phase_prenorm0(p); return; }
    const int l = (ph - 2) / PPL, s0 = (ph - 2) % PPL, s = s0 >= 2 ? s0 + 1 : s0;
    const bool last = (l == DEPTH - 1);

    pg8::StaticOrder S;
    if (s == 0) {
        pg8::Gemm g{(const u16*)(p.ws + WS_H), (const u16*)(p.ws + WS_WTIN) + (size_t)l * PW * DM, NROWS, PW, DM};
        S.init(NROWS, PW, (int)gridDim.x, obid());
        pg8::EpiInProj E{(u16*)(p.ws + WS_P), (u16*)(p.ws + WS_Q), (u16*)(p.ws + WS_K), (u16*)(p.ws + WS_VT), p.q_gain + l * 64, p.k_gain + l * 64, (const float*)(p.ws + WS_ROPE), last};
        pg8::gemm_phase<pg8::EpiInProj, pg8::StaticOrder, true, true>((PG8_LAS unsigned char*)lds, g, S, E);
    }
    else if (s == 1) { phase_attn(p, l, lds); phase_tokens(p, l, lds); }
    else if (s == 3) {
        const int M = (last || gridDim.x > 32) ? NLAT : NROWS;
        pg8::Gemm g{(const u16*)(p.ws + WS_YMIX), (const u16*)(p.ws + WS_WTOUT) + (size_t)l * DM * DM, M, DM, DM};
        S.init(M, DM, (int)gridDim.x, obid());
        pg8::EpiPlain E{(u16*)(p.ws + WS_H), DM};
        pg8::gemm_phase<pg8::EpiPlain, pg8::StaticOrder, true, true>((PG8_LAS unsigned char*)lds, g, S, E);
    }
    else phase_residual(p, l, lds);
}

#define XB_TMO      128
#define XB_XCNT(j)  (256  + 64 * (j))
#define XB_XSUB(j)  (1280 + 64 * (j))
#define XB_XGEN(j)  (2304 + 64 * (j))
#define XB_TOP      3328
#define XB_TOPGEN   3392
#define XCD_BAR_WORDS 3456
#define XB_SPIN_CAP (1u << 18)
#define LAS __attribute__((address_space(3)))

__device__ __forceinline__ unsigned xb_ld(unsigned* p)              { return __hip_atomic_load(p, __ATOMIC_RELAXED, __HIP_MEMORY_SCOPE_AGENT); }
__device__ __forceinline__ unsigned xb_add(unsigned* p, unsigned v) { return __hip_atomic_fetch_add(p, v, __ATOMIC_RELAXED, __HIP_MEMORY_SCOPE_AGENT); }
__device__ __forceinline__ unsigned xb_xcc_id() { return (unsigned)__builtin_amdgcn_s_getreg((3 << 11) | 20) & 0xFu; }
#define XB_SPIN(cond, bar) do { unsigned _sp = 0; while (cond) { __builtin_amdgcn_s_sleep(1); \
    if ((++_sp & 255u) == 0u) { if (xb_ld(&(bar)[XB_TMO])) break; if (_sp > XB_SPIN_CAP) { atomicAdd(&(bar)[XB_TMO], 1u); break; } } } } while (0)

struct XcdBarrier {
    unsigned* bar; unsigned x;
    volatile LAS unsigned* st;
};

__device__ __forceinline__ XcdBarrier xcd_barrier_post(unsigned* bar, volatile LAS unsigned* st) {
    XcdBarrier b; b.bar = bar; b.x = xb_xcc_id(); b.st = st;
    if (threadIdx.x == 0) (void)xb_add(&bar[XB_XCNT(b.x)], 1u);
    return b;
}
__device__ __forceinline__ void xcd_barrier_complete(unsigned* bar, unsigned x, unsigned& nloc, unsigned& nx) {
    const unsigned G = gridDim.x * gridDim.y * gridDim.z;
    unsigned sum, cnt, mine, sp = 0u;
    for (;;) {
        sum = 0u; cnt = 0u; mine = 0u;
#pragma unroll
        for (unsigned j = 0; j < 16; ++j) { const unsigned c = xb_ld(&bar[XB_XCNT(j)]); sum += c; cnt += (c > 0u) ? 1u : 0u; mine = (j == x) ? c : mine; }
        if (sum == G) break;
        __builtin_amdgcn_s_sleep(1);
        if ((++sp & 255u) == 0u) { if (xb_ld(&bar[XB_TMO])) break; if (sp > XB_SPIN_CAP) { atomicAdd(&bar[XB_TMO], 1u); break; } }
    }
    nloc = mine > 0u ? mine : 1u; nx = cnt > 0u ? cnt : 1u;
}

__device__ __forceinline__ void xcd_barrier(const XcdBarrier& b) {
    asm volatile("s_waitcnt vmcnt(0)" ::: "memory");
    __syncthreads();
    if (threadIdx.x == 0) {
        unsigned* bar = b.bar;
        __builtin_amdgcn_s_waitcnt(0);
        unsigned nloc = b.st[0], nx = b.st[1];
        if (nloc == 0u) { xcd_barrier_complete(bar, b.x, nloc, nx); b.st[0] = nloc; b.st[1] = nx; }
        const unsigned old = xb_add(&bar[XB_XSUB(b.x)], 1u);
        const unsigned gen = old / nloc;
        if (old + 1u == (gen + 1u) * nloc) {
            __builtin_amdgcn_fence(__ATOMIC_RELEASE, "agent");
            asm volatile("s_waitcnt vmcnt(0)" ::: "memory");
            const unsigned og = xb_add(&bar[XB_TOP], 1u);
            const unsigned tg = og / nx;
            if (og + 1u == (tg + 1u) * nx) xb_add(&bar[XB_TOPGEN], 1u);
            else XB_SPIN(xb_ld(&bar[XB_TOPGEN]) == tg, bar);
            __builtin_amdgcn_fence(__ATOMIC_ACQUIRE, "agent");
            xb_add(&bar[XB_XGEN(b.x)], 1u);
            asm volatile("s_waitcnt vmcnt(0)" ::: "memory");
        } else {
            XB_SPIN(xb_ld(&bar[XB_XGEN(b.x)]) == gen, bar);
            __builtin_amdgcn_fence(__ATOMIC_ACQUIRE, "agent");
            asm volatile("s_waitcnt vmcnt(0)" ::: "memory");
        }
    }
    __syncthreads();
}


template <bool COOP>
__global__ void __launch_bounds__(NTHREADS) fwd_kernel(Params p) {
    extern __shared__ __attribute__((aligned(16))) unsigned char lds[];
    if (COOP) {
        cg::grid_group grid = cg::this_grid();
        volatile LAS unsigned* st = (volatile LAS unsigned*)(lds + LDS_BYTES - 32);
        if (threadIdx.x == 0) { st[0] = 0u; st[1] = 0u; }
        __syncthreads();
        XcdBarrier xb = xcd_barrier_post((unsigned*)(p.ws + WS_XBAR), st);
        for (int ph = p.ph_lo; ph < p.ph_hi; ++ph) {
            run_phase(p, ph, lds);
#ifdef REP_S
            if ((REP_S < 0 && ph == 0) || (ph >= 2 && (ph - 2) % PPL == REP_S)) { xcd_barrier(xb); run_phase(p, ph, lds); }
#endif
            if (ph + 1 < p.ph_hi) {
                if (p.ph_lo < 0) grid.sync();
                xcd_barrier(xb);
            }
        }
    } else {
        for (int ph = p.ph_lo; ph < p.ph_hi; ++ph) run_phase(p, ph, lds);
    }
}

extern "C" void kernel_launch(void* const* d_in, const int* in_sizes, int n_in, void* d_out, int out_size, void* d_ws,
                              size_t ws_size, hipStream_t stream) {
    static int grid = 0;
    if (grid == 0) {
        if (n_in != 21 || ws_size < WS_END) { fprintf(stderr, "kernel_launch: unexpected inputs (n_in %d, ws %zu, need %zu)\n", n_in, ws_size, (size_t)WS_END); grid = -1; return; }
        int dev = 0, cus = 0, per_cu = 0;
        hipGetDevice(&dev);
        hipDeviceGetAttribute(&cus, hipDeviceAttributeMultiprocessorCount, dev);
        hipFuncSetAttribute((const void*)fwd_kernel<true>, hipFuncAttributeMaxDynamicSharedMemorySize, LDS_BYTES);
        hipFuncSetAttribute((const void*)fwd_kernel<false>, hipFuncAttributeMaxDynamicSharedMemorySize, LDS_BYTES);
        hipOccupancyMaxActiveBlocksPerMultiprocessor(&per_cu, (const void*)fwd_kernel<true>, NTHREADS, LDS_BYTES);
        if (per_cu < 1) per_cu = 1;
        grid = cus * per_cu;
        (void)hipGetLastError();
    }
    if (grid < 0) return;
    Params p{};
    const float** pp = (const float**)&p;
    for (int i = 0; i < 21; ++i) pp[i] = (const float*)d_in[i];
    p.out = (float*)d_out;
    p.ws = (unsigned char*)d_ws;
#if MK_COOP
    (void)hipMemsetAsync((unsigned char*)d_ws + WS_CTR, 0, WS_END - WS_CTR, stream);
    p.ph_lo = 0; p.ph_hi = N_PHASES;
    void* args[] = {&p};
    hipError_t e = hipLaunchCooperativeKernel((const void*)fwd_kernel<true>, dim3(grid), dim3(NTHREADS), args, LDS_BYTES, stream);
    if (e != hipSuccess) fprintf(stderr, "cooperative launch failed: %s (grid %d)\n", hipGetErrorString(e), grid);
#else
    for (int ph = 0; ph < N_PHASES; ++ph) {
        p.ph_lo = ph; p.ph_hi = ph + 1;
        hipLaunchKernelGGL(fwd_kernel<false>, dim3(grid), dim3(NTHREADS), LDS_BYTES, stream, p);
    }
#endif
}
```
